# Optimizing an MI355X kernel written in HIP

```python
import math
import jax, jax.numpy as jnp
from jax import lax
import numpy as np

D_MODEL = 1024
BATCH = 8
SEQ = 4096
DEPTH = 4

N_POOL_LAYERS = DEPTH // 2
N_ATTN_LAYERS = DEPTH - N_POOL_LAYERS
POOL_WINDOWS = (2, 4, 8, 16)
N_POOL_GROUPS = len(POOL_WINDOWS)
POOL_GROUP_DIM = D_MODEL // N_POOL_GROUPS
BRANCHES = ((128, 1), (512, 4), (2048, 16))
N_BRANCHES = len(BRANCHES)
HEAD_DIM = 64
N_HEADS = D_MODEL // HEAD_DIM
D_ATTN = N_HEADS * HEAD_DIM
ATTN_BLOCK = 128
D_FF = 2816
CONV_WIDTH = 3
EPS = 1e-6
ADA_SCALE = 0.5

kernel_name = "yoco_pool_dilated_alibi_hybrid"


def _rmsnorm(x, g):
    x32 = x.astype(jnp.float32)
    y = x32 * lax.rsqrt(jnp.mean(x32 * x32, axis=-1, keepdims=True) + EPS)
    return (y * g.astype(jnp.float32)).astype(x.dtype)


def _modulate(h, shift, scale):
    return h * (1 + scale[:, None, :]) + shift[:, None, :]


def _alibi_slopes(n):
    def pow2(m):
        start = 2.0 ** (-(2.0 ** -(math.log2(m) - 3)))
        return [start ** (i + 1) for i in range(m)]
    if math.log2(n).is_integer():
        s = pow2(n)
    else:
        c = 2 ** math.floor(math.log2(n))
        s = pow2(c) + pow2(2 * c)[0::2][: n - c]
    s = np.asarray(s, dtype=np.float32)
    return -np.sort(-s)


def _pool_mixer(h, w_in, w_grp, scale, w_out):
    b, s, _ = h.shape
    u = (h @ w_in).reshape(b, s, N_POOL_GROUPS, POOL_GROUP_DIM)
    u32 = u.astype(jnp.float32)
    csum = jnp.cumsum(u32, axis=1)
    t = jnp.arange(s)
    outs = []
    for g, w in enumerate(POOL_WINDOWS):
        cs = csum[:, :, g]
        lag = jnp.pad(cs, ((0, 0), (w, 0), (0, 0)))[:, :s]
        count = jnp.minimum(t + 1, w).astype(jnp.float32)[None, :, None]
        pooled = (cs - lag) / count - u32[:, :, g]
        outs.append(jnp.einsum('bsc,cd->bsd', pooled.astype(h.dtype), w_grp[g]))
    y = jnp.concatenate(outs, axis=-1) * scale
    return y @ w_out


def _causal_dwconv(a, w, bias):
    s = a.shape[1]
    ap = jnp.pad(a, ((0, 0), (CONV_WIDTH - 1, 0), (0, 0)))
    y = bias
    for k in range(CONV_WIDTH):
        y = y + ap[:, k:k + s] * w[k]
    return y


def _conv_ffn(h, w_up, conv_w, conv_b, w_down):
    a, v = jnp.split(h @ w_up, 2, axis=-1)
    a = _causal_dwconv(a, conv_w, conv_b)
    return (jax.nn.silu(a) * v) @ w_down


def _dilated_branch(q, k, v, window, dilation, slopes):
    b, s, h, dh = q.shape
    n_steps = window // dilation
    blk = max(ATTN_BLOCK, n_steps)
    sub_len = s // dilation
    nb = -(-sub_len // blk)
    sub_pad = nb * blk

    def to_sub(t):
        t = t.reshape(b, sub_len, dilation, h, dh).transpose(0, 2, 1, 3, 4).reshape(b * dilation, sub_len, h, dh)
        return jnp.pad(t, ((0, 0), (0, sub_pad - sub_len), (0, 0), (0, 0)))

    def with_prev(t):
        tb = t.reshape(-1, nb, blk, h, dh)
        prev = jnp.pad(tb, ((0, 0), (1, 0), (0, 0), (0, 0), (0, 0)))[:, :nb]
        return jnp.concatenate([prev, tb], axis=2)

    qb = to_sub(q).reshape(-1, nb, blk, h, dh)
    kb = with_prev(to_sub(k))
    vb = with_prev(to_sub(v))

    scores = jnp.einsum('bnqhd,bnkhd->bnhqk', qb, kb).astype(jnp.float32) * (dh ** -0.5)
    qi = jnp.arange(blk)[:, None] + blk
    ki = jnp.arange(2 * blk)[None, :]
    delta = qi - ki
    key_idx = jnp.arange(nb)[:, None] * blk + jnp.arange(2 * blk)[None, :] - blk
    valid = ((delta >= 0) & (delta <= n_steps))[None] & (key_idx >= 0)[:, None, :]
    bias = -slopes[:, None, None] * (delta * dilation).astype(jnp.float32)[None]
    scores = jnp.where(valid[None, :, None], scores + bias[None, None], -jnp.inf)
    lse = jax.nn.logsumexp(scores, axis=-1)
    p = jnp.exp(scores - lse[..., None])
    out = jnp.einsum('bnhqk,bnkhd->bnqhd', p.astype(v.dtype), vb)

    out = out.reshape(b, dilation, sub_pad, h, dh)[:, :, :sub_len]
    out = out.transpose(0, 2, 1, 3, 4).reshape(b, s, h, dh)
    lse = lse.transpose(0, 1, 3, 2).reshape(b, dilation, sub_pad, h)[:, :, :sub_len]
    lse = lse.transpose(0, 2, 1, 3).reshape(b, s, h)
    return out, lse


def _dilated_attention(h, kv, w_q, w_o, slopes):
    b, s, _ = h.shape
    q = (h @ w_q).reshape(b, s, N_BRANCHES, N_HEADS, HEAD_DIM)
    outs, lses = [], []
    for g, (window, dil) in enumerate(BRANCHES):
        o, l = _dilated_branch(q[:, :, g], kv[:, :, 0, g], kv[:, :, 1, g], window, dil, slopes[g])
        outs.append(o)
        lses.append(l)
    wts = jax.nn.softmax(jnp.stack(lses, axis=0), axis=0)
    o = jnp.sum(wts[..., None] * jnp.stack(outs, axis=0).astype(jnp.float32), axis=0)
    return o.reshape(b, s, D_ATTN).astype(h.dtype) @ w_o


def setup_inputs(seed: int = 0) -> dict:
    key = jax.random.key(seed)
    ks = jax.random.split(key, 24)

    def nrm(k, shape, scale):
        return jax.random.normal(k, shape, jnp.float32) * scale

    D, F, G = D_MODEL, D_FF, N_BRANCHES
    return {
        "x": nrm(ks[0], (BATCH, SEQ, D), 1.0),
        "c": nrm(ks[1], (BATCH, D), 1.0),
        "ada_w": nrm(ks[2], (DEPTH, D, 6 * D), ADA_SCALE * D ** -0.5),
        "ada_b": nrm(ks[3], (DEPTH, 6 * D), 0.02),
        "norm1_g": 1.0 + nrm(ks[4], (DEPTH, D), 0.05),
        "norm2_g": 1.0 + nrm(ks[5], (DEPTH, D), 0.05),
        "pool_w_in": nrm(ks[6], (N_POOL_LAYERS, D, D), D ** -0.5),
        "pool_w_grp": nrm(ks[7], (N_POOL_LAYERS, N_POOL_GROUPS, POOL_GROUP_DIM, POOL_GROUP_DIM), POOL_GROUP_DIM ** -0.5),
        "pool_scale": 1.0 + nrm(ks[8], (N_POOL_LAYERS, D), 0.1),
        "pool_w_out": nrm(ks[9], (N_POOL_LAYERS, D, D), D ** -0.5),
        "kv_norm_g": 1.0 + nrm(ks[10], (D,), 0.05),
        "kv_ada_w": nrm(ks[11], (D, 2 * D), ADA_SCALE * D ** -0.5),
        "kv_ada_b": nrm(ks[12], (2 * D,), 0.02),
        "w_kv": nrm(ks[13], (D, 2 * G * D_ATTN), D ** -0.5),
        "attn_w_q": nrm(ks[14], (N_ATTN_LAYERS, D, G * D_ATTN), D ** -0.5),
        "attn_w_o": nrm(ks[15], (N_ATTN_LAYERS, D_ATTN, D), D_ATTN ** -0.5),
        "ffn_w_up": nrm(ks[16], (DEPTH, D, 2 * F), D ** -0.5),
        "ffn_conv_w": nrm(ks[17], (DEPTH, CONV_WIDTH, F), CONV_WIDTH ** -0.5),
        "ffn_conv_b": nrm(ks[18], (DEPTH, F), 0.02),
        "ffn_w_down": nrm(ks[19], (DEPTH, F, D), F ** -0.5),
        "final_g": 1.0 + nrm(ks[20], (D,), 0.05),
    }


def reference(x, c, ada_w, ada_b, norm1_g, norm2_g, pool_w_in, pool_w_grp, pool_scale, pool_w_out,
              kv_norm_g, kv_ada_w, kv_ada_b, w_kv, attn_w_q, attn_w_o,
              ffn_w_up, ffn_conv_w, ffn_conv_b, ffn_w_down, final_g):
    b, s, _ = x.shape
    cond = jax.nn.silu(c)
    slopes = jnp.asarray(_alibi_slopes(N_BRANCHES * N_HEADS)).reshape(N_BRANCHES, N_HEADS)
    kv = None
    for layer in range(DEPTH):
        mod = cond @ ada_w[layer] + ada_b[layer]
        sh1, sc1, g1, sh2, sc2, g2 = jnp.split(mod, 6, axis=-1)
        h = _modulate(_rmsnorm(x, norm1_g[layer]), sh1, sc1)
        if layer < N_POOL_LAYERS:
            y = _pool_mixer(h, pool_w_in[layer], pool_w_grp[layer], pool_scale[layer], pool_w_out[layer])
        else:
            if layer == N_POOL_LAYERS:
                kv_shift, kv_scale = jnp.split(cond @ kv_ada_w + kv_ada_b, 2, axis=-1)
                hkv = _modulate(_rmsnorm(x, kv_norm_g), kv_shift, kv_scale)
                kv = (hkv @ w_kv).reshape(b, s, 2, N_BRANCHES, N_HEADS, HEAD_DIM)
            j = layer - N_POOL_LAYERS
            y = _dilated_attention(h, kv, attn_w_q[j], attn_w_o[j], slopes)
        x = x + g1[:, None, :] * y
        h = _modulate(_rmsnorm(x, norm2_g[layer]), sh2, sc2)
        x = x + g2[:, None, :] * _conv_ffn(h, ffn_w_up[layer], ffn_conv_w[layer], ffn_conv_b[layer], ffn_w_down[layer])
    return _rmsnorm(x, final_g)
```

```cpp
#include <hip/hip_runtime.h>
#include <hip/hip_cooperative_groups.h>
#include <cstdio>
#include <cstdint>
#include <cmath>
namespace cg = cooperative_groups;

#define LAS __attribute__((address_space(3)))
typedef unsigned short bf16_t;
typedef short bf16x8 __attribute__((ext_vector_type(8)));
typedef short s16x4 __attribute__((ext_vector_type(4)));
typedef float f32x4 __attribute__((ext_vector_type(4)));
typedef float f32x16 __attribute__((ext_vector_type(16)));
typedef unsigned u32x4 __attribute__((ext_vector_type(4)));
typedef unsigned u32x2 __attribute__((ext_vector_type(2)));

constexpr int SEQ = 4096, DM = 1024, NB = 8, MTOT = NB * SEQ, FF = 2816, NUP = 2 * FF, DEPTH = 4;
constexpr int MC = 16384;
constexpr float EPS = 1e-6f;
constexpr float LOG2E = 1.4426950408889634f;
constexpr int NTHREADS = 512, NWAVES = 8;
constexpr int LDS_BYTES = 147456;

constexpr size_t MiB = 1u << 20;
constexpr size_t WS_MOD = 0;
constexpr size_t WS_KVMOD = 4 * 8 * 6144 * 4;
constexpr size_t WS_BAR = 896 * 1024;
constexpr size_t WA_WIN = 1 * MiB;
constexpr size_t WA_WGRP = 5 * MiB;
constexpr size_t WA_WOUT = 6 * MiB;
constexpr size_t WA_WUP = 10 * MiB;
constexpr size_t WA_WDN = 32 * MiB;
constexpr size_t WA_H = 44 * MiB;
constexpr size_t WA_AV = 108 * MiB;
constexpr size_t WA_U = 108 * MiB, WA_PB = 172 * MiB, WA_Y = 236 * MiB;
constexpr size_t WB_WKV = 1 * MiB;
constexpr size_t WB_WQ = 13 * MiB;
constexpr size_t WB_WO = 25 * MiB;
constexpr size_t WB_WUP = 29 * MiB;
constexpr size_t WB_WDN = 51 * MiB;
constexpr size_t WB_H = 62 * MiB;
constexpr size_t WB_LSE = 94 * MiB;
constexpr size_t WB_KV = 97 * MiB;
constexpr size_t WB_Q = 289 * MiB;
constexpr size_t WB_AV = 289 * MiB;
constexpr size_t WB_H2 = 480 * MiB;
constexpr size_t WS_XTAIL = 128 * MiB;
constexpr size_t WS_HALO = 470 * MiB;
constexpr size_t WS_RAW0 = 474 * MiB;

__device__ __forceinline__ unsigned f2bf(float f) { unsigned u = __builtin_bit_cast(unsigned, f); return (u + 0x7fffu + ((u >> 16) & 1u)) >> 16; }
__device__ __forceinline__ unsigned cvt_pk_bf16(float lo, float hi) { unsigned r; asm volatile("v_cvt_pk_bf16_f32 %0, %1, %2" : "=v"(r) : "v"(lo), "v"(hi)); return r; }
__device__ __forceinline__ unsigned pk2(float lo, float hi) { unsigned r; asm("v_cvt_pk_bf16_f32 %0, %1, %2" : "=v"(r) : "v"(lo), "v"(hi)); return r; }
__device__ __forceinline__ float bflo(unsigned w) { return __builtin_bit_cast(float, w << 16); }
__device__ __forceinline__ float bfhi(unsigned w) { return __builtin_bit_cast(float, w & 0xffff0000u); }
__device__ __forceinline__ float wave_sum(float v) {
#pragma unroll
    for (int o = 1; o < 64; o <<= 1) v += __shfl_xor(v, o);
    return v;
}
#define LDS_WAIT() asm volatile("s_waitcnt lgkmcnt(0)" ::: "memory")

namespace pg8 {
constexpr int BM = 256, BK = 64, HALF = 128, HTB = HALF * BK * 2, STAGE_BYTES = 8 * HTB, NXCD = 8, WGM = 8;
__host__ __device__ __forceinline__ int lds_byte(int r, int c) { const int st = (r >> 4) * 2 + (c >> 5), rr = r & 15, cc = c & 31, ob = rr * 64 + cc * 2; return st * 1024 + (ob ^ (((ob >> 9) & 1) << 5)); }
__host__ __device__ __forceinline__ void stage_rc(int b, int& R, int& C) { const int st = b / 1024, sb = b % 1024, swz = sb ^ (((sb >> 9) & 1) << 5); R = (st >> 1) * 16 + swz / 64; C = (st & 1) * 32 + (swz % 64) / 2; }
__host__ __device__ __forceinline__ int perm32(int rho) { const int n = rho >> 4, i = rho & 15; return 8 * (i >> 2) + 4 * n + (i & 3); }

struct Unit { int pm, pn; };
struct Gemm { const bf16_t* A; const bf16_t* Bt; int M, N, K, lda, ldb, a_pn_koff; };

struct StaticOrder {
    int nM, nN, nwg, G, c;
    __device__ void init(int M, int N, int G_, int c_) { nM = M / BM; nN = N / BM; nwg = nM * nN; G = G_; c = c_; }
    __device__ bool next(int i, Unit& u) const {
        const long L = (long)i * G + c; if (L >= nwg) return false;
        int wgid = (int)L; { const int q = nwg / NXCD, r = nwg % NXCD, xcd = wgid % NXCD, off = wgid / NXCD; wgid = (xcd < r ? xcd * (q + 1) : r * (q + 1) + (xcd - r) * q) + off; }
        const int nig = WGM * nN, gid = wgid / nig, fm = gid * WGM, gsz = (nM - fm) < WGM ? (nM - fm) : WGM;
        u.pm = fm + ((wgid % nig) % gsz); u.pn = (wgid % nig) / gsz; return true;
    }
};

struct EpiBf16 {
    static constexpr bool PERM = true;
    bf16_t* O; int ldc; const float* cscale;
    __device__ __forceinline__ void operator()(const f32x4 (&acc)[2][2][4][2], const Unit& u, int wr, int wc, int fr, int fq) const {
        const int row0 = u.pm * BM + wr * 64 + fr; const int col0 = u.pn * BM + wc * 32 + 8 * fq;
        f32x4 sv[2][2];
#pragma unroll
        for (int bj = 0; bj < 2; ++bj)
#pragma unroll
            for (int n = 0; n < 2; ++n) sv[bj][n] = cscale ? *(const f32x4*)(cscale + col0 + bj * HALF + 4 * n) : (f32x4){1.f, 1.f, 1.f, 1.f};
#pragma unroll
        for (int ai = 0; ai < 2; ++ai)
#pragma unroll
            for (int m = 0; m < 4; ++m) { bf16_t* rowp = O + (size_t)(row0 + ai * HALF + m * 16) * ldc + col0;
#pragma unroll
                for (int bj = 0; bj < 2; ++bj) { const f32x4 v0 = acc[ai][bj][m][0] * sv[bj][0], v1 = acc[ai][bj][m][1] * sv[bj][1];
                    u32x4 w; w.x = cvt_pk_bf16(v0[0], v0[1]); w.y = cvt_pk_bf16(v0[2], v0[3]); w.z = cvt_pk_bf16(v1[0], v1[1]); w.w = cvt_pk_bf16(v1[2], v1[3]);
                    *(u32x4*)(rowp + bj * HALF) = w; } }
    }
};
struct EpiQKV {
    static constexpr bool PERM = true;
    bf16_t* O; size_t mat_stride; float scale;
    __device__ __forceinline__ void operator()(const f32x4 (&acc)[2][2][4][2], const Unit& u, int wr, int wc, int fr, int fq) const {
        const int colt = u.pn * BM; const int t = colt >> 10; const int g = t % 3; const int sh = 2 * g; const int dm1 = (1 << sh) - 1;
        const int hd0 = ((colt & 1023) >> 6) + (wc >> 1);
        bf16_t* base = O + (size_t)t * mat_stride + (size_t)hd0 * MC * 64 + (wc & 1) * 32 + 8 * fq;
        const int row0 = u.pm * BM + wr * 64 + fr;
#pragma unroll
        for (int ai = 0; ai < 2; ++ai)
#pragma unroll
            for (int m = 0; m < 4; ++m) { const int r = row0 + ai * HALF + m * 16; const int tt = r & 4095;
                const int dest = (r & ~4095) + ((tt & dm1) << (12 - sh)) + (tt >> sh);
                bf16_t* rowp = base + (size_t)dest * 64;
#pragma unroll
                for (int bj = 0; bj < 2; ++bj) { const f32x4 v0 = acc[ai][bj][m][0] * scale, v1 = acc[ai][bj][m][1] * scale;
                    u32x4 w; w.x = cvt_pk_bf16(v0[0], v0[1]); w.y = cvt_pk_bf16(v0[2], v0[3]); w.z = cvt_pk_bf16(v1[0], v1[1]); w.w = cvt_pk_bf16(v1[2], v1[3]);
                    *(u32x4*)(rowp + (size_t)bj * 2 * MC * 64) = w; } }
    }
};
template <bool BASE_F32>
struct EpiResid {
    static constexpr bool PERM = true;
    const float* base32; const bf16_t* base16; bf16_t* out; const float* gate; int row_base;
    __device__ __forceinline__ void operator()(const f32x4 (&acc)[2][2][4][2], const Unit& u, int wr, int wc, int fr, int fq) const {
        const int rowt = row_base + u.pm * BM; const int b = rowt >> 12;
        const int col0 = u.pn * BM + wc * 32 + 8 * fq; const int row0 = rowt + wr * 64 + fr;
        f32x4 gv[2][2];
#pragma unroll
        for (int bj = 0; bj < 2; ++bj)
#pragma unroll
            for (int n = 0; n < 2; ++n) gv[bj][n] = *(const f32x4*)(gate + (size_t)b * 6144 + col0 + bj * HALF + 4 * n);
        constexpr int NG = BASE_F32 ? 2 : 4;
#pragma unroll
        for (int rd = 0; rd < 8 / NG; ++rd) {
            u32x4 bw[NG][2]; f32x4 bf[BASE_F32 ? NG : 1][2][2];
#pragma unroll
            for (int mi = 0; mi < NG; ++mi) { const int gi = rd * NG + mi, ai = gi >> 2, m = gi & 3; const size_t off = (size_t)(row0 + ai * HALF + m * 16) * DM + col0;
#pragma unroll
                for (int bj = 0; bj < 2; ++bj) {
                    if (BASE_F32) { bf[BASE_F32 ? mi : 0][bj][0] = *(const f32x4*)(base32 + off + bj * HALF); bf[BASE_F32 ? mi : 0][bj][1] = *(const f32x4*)(base32 + off + bj * HALF + 4); }
                    else bw[mi][bj] = *(const u32x4*)(base16 + off + bj * HALF); } }
            asm volatile("" ::: "memory");
#pragma unroll
            for (int mi = 0; mi < NG; ++mi) { const int gi = rd * NG + mi, ai = gi >> 2, m = gi & 3; const size_t off = (size_t)(row0 + ai * HALF + m * 16) * DM + col0;
#pragma unroll
                for (int bj = 0; bj < 2; ++bj) {
                    f32x4 b0, b1;
                    if (BASE_F32) { b0 = bf[BASE_F32 ? mi : 0][bj][0]; b1 = bf[BASE_F32 ? mi : 0][bj][1]; }
                    else { const u32x4 w = bw[mi][bj]; b0 = (f32x4){bflo(w.x), bfhi(w.x), bflo(w.y), bfhi(w.y)}; b1 = (f32x4){bflo(w.z), bfhi(w.z), bflo(w.w), bfhi(w.w)}; }
                    const f32x4 v0 = b0 + gv[bj][0] * acc[ai][bj][m][0], v1 = b1 + gv[bj][1] * acc[ai][bj][m][1];
                    u32x4 w; w.x = cvt_pk_bf16(v0[0], v0[1]); w.y = cvt_pk_bf16(v0[2], v0[3]); w.z = cvt_pk_bf16(v1[0], v1[1]); w.w = cvt_pk_bf16(v1[2], v1[3]);
                    *(u32x4*)(out + off + bj * HALF) = w; } }
            asm volatile("" ::: "memory");
        }
    }
};

struct EpiConvGate {
    static constexpr bool PERM = true;
    bf16_t* G; const float* cw; const float* cb; float* halo; float* raw0; LAS float* xch;
    __device__ __forceinline__ void operator()(const f32x4 (&acc)[2][2][4][2], const Unit& u, int wr, int wc, int fr, int fq) const {
        const int lane = threadIdx.x & 63;
        const int colh = u.pn * 128 + wc * 32 + 8 * fq;
#define EA(ai, m, e) acc[ai][0][m][(e) >> 2][(e) & 3]
#define EV(ai, m, e) acc[ai][1][m][(e) >> 2][(e) & 3]
        if (fr >= 14) {
#pragma unroll
            for (int ai = 0; ai < 2; ++ai) { LAS float* xp = xch + ((((ai * 2 + wr) * 4 + wc) * 2 + (fr - 14)) * 4 + fq) * 8;
                *(LAS f32x4*)xp = acc[ai][0][3][0]; *(LAS f32x4*)(xp + 4) = acc[ai][0][3][1]; }
            if (wr == 1) { float* hp = halo + ((size_t)u.pm * 2 + (fr - 14)) * FF + colh; *(f32x4*)hp = acc[1][0][3][0]; *(f32x4*)(hp + 4) = acc[1][0][3][1]; }
        }
        asm volatile("s_waitcnt lgkmcnt(0)" ::: "memory"); __builtin_amdgcn_s_barrier(); asm volatile("" ::: "memory");
        f32x4 w0[2], w1[2], w2[2], bb[2];
#pragma unroll
        for (int nh = 0; nh < 2; ++nh) { const int colq = colh + 4 * nh; w0[nh] = *(const f32x4*)(cw + colq); w1[nh] = *(const f32x4*)(cw + FF + colq); w2[nh] = *(const f32x4*)(cw + 2 * FF + colq); bb[nh] = *(const f32x4*)(cb + colq); }
#pragma unroll
        for (int ai = 0; ai < 2; ++ai) {
            f32x4 q1[2], q2[2];
            const bool seam = (ai == 0 && wr == 0);
            if (!seam) { const int pai = wr == 1 ? ai : 0, pwr = wr == 1 ? 0 : 1; const LAS float* xp = xch + ((((pai * 2 + pwr) * 4 + wc) * 2) * 4 + fq) * 8;
#pragma unroll
                for (int nh = 0; nh < 2; ++nh) { const f32x4 p14 = *(const LAS f32x4*)(xp + 4 * nh), p15 = *(const LAS f32x4*)(xp + 32 + 4 * nh); q1[nh] = p15; q2[nh] = (fr == 1) ? p15 : p14; } }
            else { q1[0] = (f32x4){0.f, 0.f, 0.f, 0.f}; q1[1] = q1[0]; q2[0] = q1[0]; q2[1] = q1[0]; }
#pragma unroll
            for (int m = 0; m < 4; ++m) {
                u32x4 wout;
#pragma unroll
                for (int nh = 0; nh < 2; ++nh) {
                    const f32x4 av = acc[ai][0][m][nh], vv = acc[ai][1][m][nh];
                    f32x4 o;
#pragma unroll
                    for (int e = 0; e < 4; ++e) {
                        const float ac = av[e];
                        const float c1 = __builtin_bit_cast(float, __builtin_amdgcn_mov_dpp(__builtin_bit_cast(int, ac), 0x121, 0xF, 0xF, true));
                        const float c2 = __builtin_bit_cast(float, __builtin_amdgcn_mov_dpp(__builtin_bit_cast(int, ac), 0x122, 0xF, 0xF, true));
                        const float pr1 = fr >= 1 ? c1 : q1[nh][e];
                        const float pr2 = fr >= 2 ? c2 : q2[nh][e];
                        const float y = __builtin_fmaf(w2[nh][e], ac, __builtin_fmaf(w1[nh][e], pr1, __builtin_fmaf(w0[nh][e], pr2, bb[nh][e])));
                        o[e] = y * __builtin_amdgcn_rcpf(1.f + __builtin_amdgcn_exp2f(-LOG2E * y)) * vv[e];
                        q1[nh][e] = c1; q2[nh][e] = c2;
                    }
                    if (nh == 0) { wout.x = cvt_pk_bf16(o[0], o[1]); wout.y = cvt_pk_bf16(o[2], o[3]); } else { wout.z = cvt_pk_bf16(o[0], o[1]); wout.w = cvt_pk_bf16(o[2], o[3]); }
                }
                const int trow = ai * HALF + wr * 64 + m * 16 + fr;
                if (seam && m == 0 && fr < 2) {
                    float* rp = raw0 + ((size_t)u.pm * 2 + fr) * NUP + colh;
                    *(f32x4*)rp = acc[0][0][0][0]; *(f32x4*)(rp + 4) = acc[0][0][0][1]; *(f32x4*)(rp + FF) = acc[0][1][0][0]; *(f32x4*)(rp + FF + 4) = acc[0][1][0][1];
                } else *(u32x4*)(G + (size_t)(u.pm * BM + trow) * FF + colh) = wout;
            }
        }
#undef EA
#undef EV
    }
};

template <class Epi, class Sched>
__device__ __forceinline__ void gemm_phase(LAS unsigned char* lds, const Gemm g, const Sched& S, const Epi& E) {
    int tid_ = threadIdx.x; asm volatile("" : "+v"(tid_));
    const int tid = tid_, wid = __builtin_amdgcn_readfirstlane(tid >> 6), lane = tid & 63, wr = wid >> 2, wc = wid & 3, fr = lane & 15, fq = lane >> 4;
    const int K = g.K, nt = K / BK;
    unsigned voffA[2], voffB[2];
#pragma unroll
    for (int i = 0; i < 2; ++i) { int R, C; stage_rc(tid * 16 + i * 8192, R, C); const int Rb = Epi::PERM ? ((R & ~31) + perm32(R & 31)) : R;
        voffA[i] = (unsigned)(R * g.lda + C) * 2u; voffB[i] = (unsigned)(Rb * g.ldb + C) * 2u; }
    const size_t kstep = (size_t)(BK * 2);
    const size_t hstepA = (size_t)HALF * g.lda * 2, hstepB = (size_t)HALF * g.ldb * 2;
    const size_t tstepA = 2 * hstepA, tstepB = 2 * hstepB;
    const unsigned ldsw = (unsigned)wid * 1024u;
    const int aoff = lds_byte(wr * 64 + fr, fq * 8), boff = lds_byte(wc * 32 + fr, fq * 8);
#define PG8_SA(b, h) (((b) * 2 + (h)) * HTB)
#define PG8_SB(b, h) ((4 + (b) * 2 + (h)) * HTB)
#define PG8_STAGE(bufoff, gbase, voff) do { _Pragma("unroll") for (int _i = 0; _i < 2; ++_i) \
        __builtin_amdgcn_global_load_lds((const unsigned*)((const char*)(gbase) + (voff)[_i]), (LAS unsigned*)(lds + (bufoff) + ldsw + _i * 8192), 16, 0, 0); } while (0)
#define PG8_LDA(dst, b, h) do { _Pragma("unroll") for (int m = 0; m < 4; ++m) _Pragma("unroll") for (int k = 0; k < 2; ++k) dst[m][k] = *(const LAS bf16x8*)(lds + PG8_SA(b, h) + aoff + m * 2048 + k * 1024); } while (0)
#define PG8_LDB(dst, b, h) do { _Pragma("unroll") for (int n = 0; n < 2; ++n) _Pragma("unroll") for (int k = 0; k < 2; ++k) dst[n][k] = *(const LAS bf16x8*)(lds + PG8_SB(b, h) + boff + n * 2048 + k * 1024); } while (0)
#define PG8_MMA(ai, bj, At, Bt) do { __builtin_amdgcn_s_setprio(3); _Pragma("unroll") for (int m = 0; m < 4; ++m) _Pragma("unroll") for (int n = 0; n < 2; ++n) _Pragma("unroll") for (int k = 0; k < 2; ++k) \
        acc[ai][bj][m][n] = __builtin_amdgcn_mfma_f32_16x16x32_bf16(Bt[n][k], At[m][k], acc[ai][bj][m][n], 0, 0, 0); __builtin_amdgcn_s_setprio(0); } while (0)
#define PG8_WAIT_V(n) asm volatile("s_waitcnt vmcnt(" #n ")" ::: "memory")
#define PG8_WAIT_L(n) asm volatile("s_waitcnt lgkmcnt(" #n ")" ::: "memory")
#define PG8_BAR __builtin_amdgcn_s_barrier()
#define PG8_SCHED __builtin_amdgcn_sched_barrier(0)
#define PG8_BASEA(un) ((const char*)g.A + (size_t)(un).pm * tstepA + (size_t)(un).pn * (size_t)g.a_pn_koff * 2)
#define PG8_BASEB(un) ((const char*)g.Bt + (size_t)(un).pn * tstepB)
    Unit cur, nxt; int ui = 0;
    if (!S.next(0, cur)) return;
    f32x4 acc[2][2][4][2];
#pragma unroll
    for (int a = 0; a < 2; ++a)
#pragma unroll
        for (int b = 0; b < 2; ++b)
#pragma unroll
            for (int m = 0; m < 4; ++m)
#pragma unroll
                for (int n = 0; n < 2; ++n) acc[a][b][m][n] = (f32x4){0.f, 0.f, 0.f, 0.f};
    bf16x8 At[4][2], B0[2][2], B1[2][2];
    const char* cA = PG8_BASEA(cur); const char* cB = PG8_BASEB(cur);
    PG8_STAGE(PG8_SB(0, 0), cB, voffB); PG8_STAGE(PG8_SB(0, 1), cB + hstepB, voffB); PG8_STAGE(PG8_SA(0, 0), cA, voffA); PG8_STAGE(PG8_SA(0, 1), cA + hstepA, voffA);
    if (wr == 1) PG8_BAR;
    PG8_WAIT_V(2); PG8_BAR;
    PG8_STAGE(PG8_SB(1, 0), cB + kstep, voffB); PG8_STAGE(PG8_SA(1, 0), cA + kstep, voffA); PG8_STAGE(PG8_SB(1, 1), cB + hstepB + kstep, voffB);
    PG8_WAIT_V(6); PG8_BAR;
    for (;;) {
        const bool has_next = S.next(ui + 1, nxt);
        const char* nA = has_next ? PG8_BASEA(nxt) : cA; const char* nB = has_next ? PG8_BASEB(nxt) : cB;
        for (int t = 0; t < nt; t += 2) {
            const bool last = (t == nt - 2);
            const char* a1 = cA + (size_t)(t + 1) * kstep;
            const char* a2 = last ? nA : cA + (size_t)(t + 2) * kstep; const char* b2 = last ? nB : cB + (size_t)(t + 2) * kstep;
            const char* a3 = a2 + kstep; const char* b3 = b2 + kstep;
            PG8_LDB(B0, 0, 0); PG8_LDB(B1, 0, 1); PG8_SCHED; PG8_LDA(At, 0, 0); PG8_STAGE(PG8_SA(1, 1), a1 + hstepA, voffA);
            PG8_WAIT_V(8); PG8_WAIT_L(0); PG8_BAR; PG8_MMA(0, 0, At, B0); PG8_MMA(0, 1, At, B1); PG8_BAR; PG8_SCHED;
            PG8_LDA(At, 0, 1); PG8_STAGE(PG8_SB(0, 0), b2, voffB); PG8_STAGE(PG8_SB(0, 1), b2 + hstepB, voffB); PG8_STAGE(PG8_SA(0, 0), a2, voffA);
            PG8_WAIT_V(8); PG8_WAIT_L(0); PG8_BAR; PG8_MMA(1, 0, At, B0); PG8_MMA(1, 1, At, B1); PG8_BAR; PG8_SCHED;
            PG8_LDB(B0, 1, 0); PG8_LDB(B1, 1, 1); PG8_SCHED; PG8_LDA(At, 1, 0); PG8_STAGE(PG8_SA(0, 1), a2 + hstepA, voffA);
            PG8_WAIT_V(8); PG8_WAIT_L(0); PG8_BAR; PG8_MMA(0, 0, At, B0); PG8_MMA(0, 1, At, B1); PG8_BAR; PG8_SCHED;
            PG8_LDA(At, 1, 1); PG8_STAGE(PG8_SB(1, 0), b3, voffB); PG8_STAGE(PG8_SB(1, 1), b3 + hstepB, voffB); PG8_STAGE(PG8_SA(1, 0), a3, voffA);
            PG8_WAIT_V(8); PG8_WAIT_L(0); PG8_BAR; PG8_MMA(1, 0, At, B0); PG8_MMA(1, 1, At, B1); PG8_BAR; PG8_SCHED;
        }
        if (wr == 0) PG8_BAR;
        E(acc, cur, wr, wc, fr, fq);
        if (!has_next) break;
#pragma unroll
        for (int a = 0; a < 2; ++a)
#pragma unroll
            for (int b = 0; b < 2; ++b)
#pragma unroll
                for (int m = 0; m < 4; ++m)
#pragma unroll
                    for (int n = 0; n < 2; ++n) acc[a][b][m][n] = (f32x4){0.f, 0.f, 0.f, 0.f};
        cur = nxt; cA = nA; cB = nB; ++ui;
        if (wr == 1) PG8_BAR;
    }
    PG8_WAIT_V(0);
    PG8_BAR;
#undef PG8_SA
#undef PG8_SB
#undef PG8_STAGE
#undef PG8_LDA
#undef PG8_LDB
#undef PG8_MMA
#undef PG8_WAIT_V
#undef PG8_WAIT_L
#undef PG8_BAR
#undef PG8_SCHED
#undef PG8_BASEA
#undef PG8_BASEB
}
}

struct Ctx { LAS unsigned char* lds; int tid, lane, wave, bid, G; };
__device__ __forceinline__ Ctx relaunder(const Ctx& F0) { Ctx F = F0; int t = threadIdx.x; asm volatile("" : "+v"(t)); F.tid = t; F.lane = t & 63; F.wave = __builtin_amdgcn_readfirstlane(t >> 6); return F; }

template <bool AVPERM>
__device__ __forceinline__ void transpose_item(const float* W, int K, int N, bf16_t* WT, int row_off, LAS float* scr, int item, int lane) {
    const int nblk = N / 32, kb = item / nblk, nb = item % nblk, k0 = 64 * kb, n0 = 32 * nb;
    const int d0 = AVPERM ? (n0 < FF ? (n0 >> 7) * 256 + (n0 & 127) : ((n0 - FF) >> 7) * 256 + 128 + ((n0 - FF) & 127)) : n0;
    float wv[32];
#pragma unroll
    for (int i = 0; i < 32; ++i) { const int kk = 2 * i + (lane >> 5); wv[i] = W[(size_t)(k0 + kk) * N + n0 + (lane & 31)]; }
#pragma unroll
    for (int i = 0; i < 32; ++i) { const int kk = 2 * i + (lane >> 5); scr[kk * 33 + (lane & 31)] = wv[i]; }
    LDS_WAIT(); asm volatile("" ::: "memory");
    const int c = lane & 7;
#pragma unroll
    for (int j = 0; j < 4; ++j) { const int n = (lane >> 3) + 8 * j; const LAS float* s = scr + (8 * c) * 33 + n;
        u32x4 o; o.x = pk2(s[0 * 33], s[1 * 33]); o.y = pk2(s[2 * 33], s[3 * 33]); o.z = pk2(s[4 * 33], s[5 * 33]); o.w = pk2(s[6 * 33], s[7 * 33]);
        *(u32x4*)(WT + (size_t)(row_off + d0 + n) * K + k0 + 8 * c) = o; }
    LDS_WAIT(); asm volatile("" ::: "memory");
}
template <bool AVPERM = false>
__device__ __forceinline__ void transpose_matrix(const Ctx& F0, const float* W, int K, int N, bf16_t* WT, int row_off) {
    const Ctx F = relaunder(F0);
    LAS float* scr = (LAS float*)(F.lds + F.wave * 16384);
    const int gw = F.bid * NWAVES + F.wave, NGW = F.G * NWAVES, items = (K / 64) * (N / 32);
    for (int it = gw; it < items; it += NGW) transpose_item<AVPERM>(W, K, N, WT, row_off, scr, it, F.lane);
}

__device__ __forceinline__ void unpack8(const u32x4 w, float (&f)[8]) { f[0] = bflo(w.x); f[1] = bfhi(w.x); f[2] = bflo(w.y); f[3] = bfhi(w.y); f[4] = bflo(w.z); f[5] = bfhi(w.z); f[6] = bflo(w.w); f[7] = bfhi(w.w); }
__device__ __forceinline__ u32x4 pack8(const float (&f)[8]) { u32x4 w; w.x = pk2(f[0], f[1]); w.y = pk2(f[2], f[3]); w.z = pk2(f[4], f[5]); w.w = pk2(f[6], f[7]); return w; }

__device__ __forceinline__ void fold_pool_weights(const Ctx& F0, const float* wgrp, const float* pscale, const float* wout, bf16_t* WT) {
    const Ctx F = relaunder(F0);
    LAS float* WgS = (LAS float*)F.lds;
    LAS float* WoS = WgS + 4096;
    __syncthreads();
    for (int t = F.bid; t < 512; t += F.G) {
        const int L = t >> 8, kt = (t >> 4) & 15, nt = t & 15, k0 = kt * 64, n0 = nt * 64, g = k0 >> 8;
        const float* Wg = wgrp + (size_t)(L * 4 + g) * 65536 + (size_t)(k0 & 255) * 256;
        const float* Wo = wout + (size_t)L * DM * DM + (size_t)(g * 256) * DM + n0;
        const float* sc = pscale + L * DM + g * 256;
        const int n = F.tid & 63, kg = F.tid >> 6;
        float acc[8];
#pragma unroll
        for (int e = 0; e < 8; ++e) acc[e] = 0.f;
        for (int j0 = 0; j0 < 256; j0 += 64) {
#pragma unroll
            for (int i = 0; i < 8; ++i) { const int idx = F.tid + NTHREADS * i, r = idx >> 6, c = idx & 63;
                WgS[r * 64 + c] = Wg[(size_t)r * 256 + j0 + c];
                WoS[r * 64 + c] = Wo[(size_t)(j0 + r) * DM + c] * sc[j0 + r]; }
            __syncthreads();
#pragma unroll 8
            for (int j = 0; j < 64; ++j) { const float b = WoS[j * 64 + n];
#pragma unroll
                for (int e = 0; e < 8; ++e) acc[e] += WgS[(8 * kg + e) * 64 + j] * b; }
            __syncthreads();
        }
        *(u32x4*)(WT + (size_t)L * DM * DM + (size_t)(n0 + n) * DM + k0 + 8 * kg) = pack8(acc);
    }
}

__device__ __forceinline__ void mod_phase(const Ctx& F0, const float* c, const float* ada_w, const float* ada_b, const float* kv_ada_w, const float* kv_ada_b, float* mod, float* kvmod) {
    const Ctx F = relaunder(F0);
    LAS float* condT = (LAS float*)(F.lds + 131072 - 49152);
    LAS float* part = condT + 8192;
    __syncthreads();
    for (int i = F.tid; i < 8192; i += NTHREADS) { const int b = i >> 10, k = i & 1023; const float v = c[i]; condT[k * 8 + b] = v / (1.f + __expf(-v)); }
    __syncthreads();
    for (int it = F.bid; it < 416; it += F.G) {
        const float* W; const float* bias; float* outp; int N, cb;
        if (it < 384) { const int L = it / 96; cb = it % 96; W = ada_w + (size_t)L * 1024 * 6144; N = 6144; bias = ada_b + L * 6144; outp = mod + (size_t)L * 8 * 6144; }
        else { cb = it - 384; W = kv_ada_w; N = 2048; bias = kv_ada_b; outp = kvmod; }
        const int cl = F.tid & 63, kq = F.tid >> 6, col = cb * 64 + cl;
        float a0 = 0.f, a1 = 0.f, a2 = 0.f, a3 = 0.f, a4 = 0.f, a5 = 0.f, a6 = 0.f, a7 = 0.f;
#pragma unroll 16
        for (int k = kq * 128; k < kq * 128 + 128; ++k) {
            const float w = W[(size_t)k * N + col]; const f32x4 c0 = *(const LAS f32x4*)(condT + k * 8), c1 = *(const LAS f32x4*)(condT + k * 8 + 4);
            a0 += w * c0[0]; a1 += w * c0[1]; a2 += w * c0[2]; a3 += w * c0[3]; a4 += w * c1[0]; a5 += w * c1[1]; a6 += w * c1[2]; a7 += w * c1[3];
        }
        part[(kq * 8 + 0) * 64 + cl] = a0; part[(kq * 8 + 1) * 64 + cl] = a1; part[(kq * 8 + 2) * 64 + cl] = a2; part[(kq * 8 + 3) * 64 + cl] = a3;
        part[(kq * 8 + 4) * 64 + cl] = a4; part[(kq * 8 + 5) * 64 + cl] = a5; part[(kq * 8 + 6) * 64 + cl] = a6; part[(kq * 8 + 7) * 64 + cl] = a7;
        __syncthreads();
        { const int b = F.tid >> 6; float s = bias[cb * 64 + cl];
#pragma unroll
          for (int q = 0; q < 8; ++q) s += part[(q * 8 + b) * 64 + cl];
          outp[(size_t)b * N + cb * 64 + cl] = s; }
        __syncthreads();
    }
}

template <bool XBF16>
__device__ __forceinline__ void norm_phase(const Ctx& F0, const void* Xv, bf16_t* H, const float* g, const float* shift, const float* scale, int bstride, int row0, int nrows) {
    const Ctx F = relaunder(F0);
    const int gw = F.bid * NWAVES + F.wave, NGW = F.G * NWAVES;
    const int rpw = (nrows + NGW - 1) / NGW;
    int r = row0 + gw * rpw; const int rend = min(row0 + nrows, r + rpw);
    int curb = -1; f32x4 gs[4], shv[4];
    for (; r < rend; ++r) {
        const int b = r >> 12;
        if (b != curb) { curb = b;
#pragma unroll
            for (int j = 0; j < 4; ++j) { const int col = 4 * F.lane + 256 * j; const f32x4 gg = *(const f32x4*)(g + col), sc = *(const f32x4*)(scale + (size_t)b * bstride + col);
                gs[j] = gg * (sc + 1.f); shv[j] = *(const f32x4*)(shift + (size_t)b * bstride + col); } }
        f32x4 v[4]; float ss = 0.f;
        if (XBF16) { const u32x2* xr = (const u32x2*)((const bf16_t*)Xv + (size_t)r * DM) + F.lane;
#pragma unroll
            for (int j = 0; j < 4; ++j) { const u32x2 w = xr[64 * j]; v[j] = (f32x4){bflo(w.x), bfhi(w.x), bflo(w.y), bfhi(w.y)}; } }
        else { const f32x4* xr = (const f32x4*)((const float*)Xv + (size_t)r * DM) + F.lane;
#pragma unroll
            for (int j = 0; j < 4; ++j) v[j] = xr[64 * j]; }
#pragma unroll
        for (int j = 0; j < 4; ++j) ss += (v[j].x * v[j].x + v[j].y * v[j].y) + (v[j].z * v[j].z + v[j].w * v[j].w);
        const float rstd = 1.f / sqrtf(wave_sum(ss) * (1.f / DM) + EPS);
        u32x2* o8 = (u32x2*)(H + (size_t)(r - row0) * DM) + F.lane;
#pragma unroll
        for (int j = 0; j < 4; ++j) { const f32x4 y = v[j] * rstd * gs[j] + shv[j]; u32x2 w; w.x = pk2(y.x, y.y); w.y = pk2(y.z, y.w); o8[64 * j] = w; }
    }
}
__device__ __forceinline__ void norm_dual_phase(const Ctx& F0, const bf16_t* X, bf16_t* Ha, const float* ga, const float* shift_a, const float* scale_a, int bstride_a,
                                                bf16_t* Hb, const float* gb, const float* shift_b, const float* scale_b, int bstride_b, int row0, int nrows) {
    const Ctx F = relaunder(F0);
    const int gw = F.bid * NWAVES + F.wave, NGW = F.G * NWAVES;
    const int rpw = (nrows + NGW - 1) / NGW;
    int r = row0 + gw * rpw; const int rend = min(row0 + nrows, r + rpw);
    int curb = -1; f32x4 gsa[4], sha[4], gsb[4], shb[4];
    for (; r < rend; ++r) {
        const int b = r >> 12;
        if (b != curb) { curb = b;
#pragma unroll
            for (int j = 0; j < 4; ++j) { const int col = 4 * F.lane + 256 * j;
                gsa[j] = *(const f32x4*)(ga + col) * (*(const f32x4*)(scale_a + (size_t)b * bstride_a + col) + 1.f); sha[j] = *(const f32x4*)(shift_a + (size_t)b * bstride_a + col);
                gsb[j] = *(const f32x4*)(gb + col) * (*(const f32x4*)(scale_b + (size_t)b * bstride_b + col) + 1.f); shb[j] = *(const f32x4*)(shift_b + (size_t)b * bstride_b + col); } }
        f32x4 v[4]; float ss = 0.f;
        const u32x2* xr = (const u32x2*)(X + (size_t)r * DM) + F.lane;
#pragma unroll
        for (int j = 0; j < 4; ++j) { const u32x2 w = xr[64 * j]; v[j] = (f32x4){bflo(w.x), bfhi(w.x), bflo(w.y), bfhi(w.y)}; }
#pragma unroll
        for (int j = 0; j < 4; ++j) ss += (v[j].x * v[j].x + v[j].y * v[j].y) + (v[j].z * v[j].z + v[j].w * v[j].w);
        const float rstd = 1.f / sqrtf(wave_sum(ss) * (1.f / DM) + EPS);
        u32x2* oa = (u32x2*)(Ha + (size_t)(r - row0) * DM) + F.lane; u32x2* ob = (u32x2*)(Hb + (size_t)(r - row0) * DM) + F.lane;
#pragma unroll
        for (int j = 0; j < 4; ++j) { const f32x4 xn = v[j] * rstd; const f32x4 ya = xn * gsa[j] + sha[j], yb = xn * gsb[j] + shb[j];
            u32x2 wa; wa.x = pk2(ya.x, ya.y); wa.y = pk2(ya.z, ya.w); oa[64 * j] = wa;
            u32x2 wb; wb.x = pk2(yb.x, yb.y); wb.y = pk2(yb.z, yb.w); ob[64 * j] = wb; }
    }
}
__device__ __forceinline__ void final_norm_phase(const Ctx& F0, const bf16_t* Xs, int soff, float* out, const float* g, int r0, int r1) {
    const Ctx F = relaunder(F0);
    const int gw = F.bid * NWAVES + F.wave, NGW = F.G * NWAVES;
    f32x4 gs[4];
#pragma unroll
    for (int j = 0; j < 4; ++j) gs[j] = *(const f32x4*)(g + 4 * F.lane + 256 * j);
    for (int r = r0 + gw; r < r1; r += NGW) {
        const u32x2* xr = (const u32x2*)(Xs + (size_t)(r - soff) * DM) + F.lane;
        f32x4 v[4]; float ss = 0.f;
#pragma unroll
        for (int j = 0; j < 4; ++j) { const u32x2 w = xr[64 * j]; v[j] = (f32x4){bflo(w.x), bfhi(w.x), bflo(w.y), bfhi(w.y)}; ss += (v[j].x * v[j].x + v[j].y * v[j].y) + (v[j].z * v[j].z + v[j].w * v[j].w); }
        const float rstd = 1.f / sqrtf(wave_sum(ss) * (1.f / DM) + EPS);
        f32x4* orow = (f32x4*)(out + (size_t)r * DM) + F.lane;
#pragma unroll
        for (int j = 0; j < 4; ++j) orow[64 * j] = v[j] * rstd * gs[j];
    }
}
__device__ __forceinline__ void copy_rows_phase(const Ctx& F0, const bf16_t* src, bf16_t* dst, int nrows) {
    const Ctx F = relaunder(F0);
    const int gw = F.bid * NWAVES + F.wave, NGW = F.G * NWAVES;
    for (int r = gw; r < nrows; r += NGW) { const u32x4* s = (const u32x4*)(src + (size_t)r * DM) + F.lane; u32x4* d = (u32x4*)(dst + (size_t)r * DM) + F.lane; d[0] = s[0]; d[64] = s[64]; }
}
__device__ __forceinline__ void pool_phase(const Ctx& F0, const bf16_t* U, bf16_t* PB) {
    const Ctx F = relaunder(F0);
    const int nitems = (MTOT / 32) * 128;
    for (int it = F.bid * NTHREADS + F.tid; it < nitems; it += F.G * NTHREADS) {
        const int rb = it >> 7, ch = it & 127, t0 = rb * 32, col = ch * 8, w = 2 << (col >> 8), st0 = t0 & 4095;
        float sum[8];
#pragma unroll
        for (int e = 0; e < 8; ++e) sum[e] = 0.f;
        for (int j = 1; j <= w; ++j) if (st0 - j >= 0) { float f[8]; unpack8(*(const u32x4*)(U + (size_t)(t0 - j) * DM + col), f);
#pragma unroll
            for (int e = 0; e < 8; ++e) sum[e] += f[e]; }
        for (int i = 0; i < 32; ++i) {
            const int t = t0 + i, st = st0 + i; float ut[8]; unpack8(*(const u32x4*)(U + (size_t)t * DM + col), ut);
#pragma unroll
            for (int e = 0; e < 8; ++e) sum[e] += ut[e];
            if (st >= w) { float f[8]; unpack8(*(const u32x4*)(U + (size_t)(t - w) * DM + col), f);
#pragma unroll
                for (int e = 0; e < 8; ++e) sum[e] -= f[e]; }
            const float inv = 1.f / (float)min(st + 1, w); float o[8];
#pragma unroll
            for (int e = 0; e < 8; ++e) o[e] = sum[e] * inv - ut[e];
            *(u32x4*)(PB + (size_t)t * DM + col) = pack8(o);
        }
    }
}

template <class Sched>
__device__ __forceinline__ void conv_fix_units(const Ctx& F0, const Sched& S, bf16_t* G, const float* cw, const float* cb, const float* halo, const float* raw0, int row0) {
    const Ctx F = relaunder(F0);
    pg8::Unit u;
    for (int i = 0; S.next(i, u); ++i) {
        const int tile = u.pm;
        if (F.tid < 352) {
            const int col = F.tid * 8;
            const bool seq0 = (((row0 + tile * 256) & 4095) == 0);
            float h254[8], h255[8];
#pragma unroll
            for (int e = 0; e < 8; ++e) { h254[e] = 0.f; h255[e] = 0.f; }
            if (!seq0) { const float* hp = halo + ((size_t)(tile - 1) * 2) * FF + col;
#pragma unroll
                for (int e = 0; e < 8; ++e) { h254[e] = hp[e]; h255[e] = hp[FF + e]; } }
            const float* rp = raw0 + ((size_t)tile * 2) * NUP + col;
            float o0[8], o1[8];
#pragma unroll
            for (int e = 0; e < 8; ++e) { const float a0 = rp[e], v0 = rp[FF + e], a1 = rp[NUP + e], v1 = rp[NUP + FF + e];
                const float w0 = cw[col + e], w1 = cw[FF + col + e], w2 = cw[2 * FF + col + e], bb = cb[col + e];
                const float y0 = bb + w0 * h254[e] + w1 * h255[e] + w2 * a0, y1 = bb + w0 * h255[e] + w1 * a0 + w2 * a1;
                o0[e] = y0 / (1.f + __expf(-y0)) * v0; o1[e] = y1 / (1.f + __expf(-y1)) * v1; }
            *(u32x4*)(G + (size_t)(tile * 256) * FF + col) = pack8(o0); *(u32x4*)(G + (size_t)(tile * 256 + 1) * FF + col) = pack8(o1);
        }
    }
    asm volatile("s_waitcnt vmcnt(0)" ::: "memory");
    __syncthreads();
}

__device__ __forceinline__ int crow(int r, int hi) { return (r & 3) + 8 * (r >> 2) + 4 * hi; }
__device__ __forceinline__ void attn_phase(const Ctx& F0, bf16_t* Qc, const bf16_t* KVc, float* LSE) {
    const Ctx F = relaunder(F0);
    LAS unsigned char* lds = F.lds;
    const int tid = F.tid, lane = F.lane, wid = F.wave, q = lane & 31, hi = lane >> 5;
    constexpr size_t MAT = (size_t)MC * 1024;
    constexpr int VOFF = 49152, NUNITS = 3072;
    const int q4 = (lane & 15) >> 2, p4 = lane & 3, dc16 = (lane >> 4) & 1;
    const int slot_l = tid >> 3, c_l = tid & 7;
    u32x4 kreg[6], vreg[6]; bf16x8 qn[4];
#define ATT_DECODE(u, h, rb, g, sh, prow0, has_prev) const int h = (u) & 15, rb = ((u) >> 4) & 63, g = (u) >> 10, sh = 2 * g, prow0 = rb * 256; const bool has_prev = ((prow0 & ((4096 >> sh) - 1)) != 0)
#define ATT_ISSUE(u) do { ATT_DECODE(u, h_, rb_, g_, sh_, prow0_, hp_); \
        const bf16_t* Kg_ = KVc + (size_t)g_ * MAT + (size_t)h_ * MC * 64 + c_l * 8; const bf16_t* Vg_ = KVc + (size_t)(3 + g_) * MAT + (size_t)h_ * MC * 64 + c_l * 8; \
        _Pragma("unroll") for (int i = 0; i < 6; ++i) if (hp_ || i >= 2) { const long prow = (long)prow0_ - 128 + slot_l + 64 * i; kreg[i] = *(const u32x4*)(Kg_ + prow * 64); vreg[i] = *(const u32x4*)(Vg_ + prow * 64); } \
        const bf16_t* Qw_ = Qc + (size_t)g_ * MAT + ((size_t)h_ * MC + prow0_ + 32 * wid + q) * 64; \
        _Pragma("unroll") for (int s = 0; s < 4; ++s) qn[s] = *(const bf16x8*)(Qw_ + 16 * s + 8 * hi); } while (0)
    int u = F.bid;
    if (u < NUNITS) ATT_ISSUE(u);
    while (u < NUNITS) {
        ATT_DECODE(u, h, rb, g, sh, prow0, has_prev);
        bf16_t* Qw = Qc + (size_t)g * MAT + ((size_t)h * MC + prow0 + 32 * wid + q) * 64;
        bf16x8 qf[4];
#pragma unroll
        for (int s = 0; s < 4; ++s) qf[s] = qn[s];
#pragma unroll
        for (int i = 0; i < 6; ++i) if (has_prev || i >= 2) { const int slot = slot_l + 64 * i;
            *(LAS u32x4*)(lds + slot * 128 + ((c_l ^ ((slot >> 1) & 7)) << 4)) = kreg[i];
            *(LAS u32x4*)(lds + VOFF + slot * 128 + ((c_l << 4) ^ (((slot >> 1) & 1) << 6))) = vreg[i]; }
        __syncthreads();
        const int un = u + F.G;
        if (un < NUNITS) ATT_ISSUE(un);
        const int ii = g * 16 + h; const float ee = ii < 32 ? 0.125f * (float)(ii + 1) : 4.0f + 0.25f * (float)(ii - 31);
        const float slope2 = exp2f(-ee) * (float)(1 << sh) * LOG2E;
        float mx = -INFINITY, lsum = 0.f;
        f32x16 o0 = {0.f, 0.f, 0.f, 0.f, 0.f, 0.f, 0.f, 0.f, 0.f, 0.f, 0.f, 0.f, 0.f, 0.f, 0.f, 0.f}, o1 = o0;
        f32x16 cf;
#pragma unroll
        for (int r = 0; r < 16; ++r) cf[r] = slope2 * (float)crow(r, hi);
        const int qq = q - 4 * hi;
        const int i0 = has_prev ? 0 : (wid < 4 ? 4 - wid : 0);
#define ATT_TILE(i, MASKLO, MASKHI) do { \
            const int sb = 32 * wid + 32 * (i); \
            const float base = -slope2 * (float)(q + 128 - 32 * (i)); \
            f32x16 a; \
            _Pragma("unroll") for (int r = 0; r < 16; ++r) a[r] = cf[r] + base; \
            { const int slot = sb + q; \
              _Pragma("unroll") for (int s = 0; s < 4; ++s) { const int c = 2 * s + hi; const bf16x8 kf = *(const LAS bf16x8*)(lds + slot * 128 + ((c ^ ((slot >> 1) & 7)) << 4)); \
                  a = __builtin_amdgcn_mfma_f32_32x32x16_bf16(kf, qf[s], a, 0, 0, 0); } } \
            if (MASKHI) { _Pragma("unroll") for (int r = 0; r < 16; ++r) if (crow(r, 0) > qq) a[r] = -INFINITY; }     \
            if (MASKLO) { _Pragma("unroll") for (int r = 0; r < 16; ++r) if (crow(r, 0) < qq) a[r] = -INFINITY; }     \
            float tmax = fmaxf(fmaxf(a[0], a[1]), fmaxf(a[2], a[3])); \
            _Pragma("unroll") for (int r = 4; r < 16; r += 4) tmax = fmaxf(tmax, fmaxf(fmaxf(a[r], a[r + 1]), fmaxf(a[r + 2], a[r + 3]))); \
            tmax = fmaxf(tmax, __shfl_xor(tmax, 32)); \
            if (__any(tmax > mx)) { const float mnew = fmaxf(mx, tmax); const float alpha = __builtin_amdgcn_exp2f(mx - mnew); mx = mnew; lsum *= alpha; \
                _Pragma("unroll") for (int r = 0; r < 16; ++r) { o0[r] *= alpha; o1[r] *= alpha; } } \
            float ps = 0.f; \
            _Pragma("unroll") for (int r = 0; r < 16; ++r) { const float p = __builtin_amdgcn_exp2f(a[r] - mx); a[r] = p; ps += p; } \
            lsum += ps; \
            _Pragma("unroll") for (int s2 = 0; s2 < 2; ++s2) { \
                u32x4 pw; pw.x = cvt_pk_bf16(a[8 * s2 + 0], a[8 * s2 + 1]); pw.y = cvt_pk_bf16(a[8 * s2 + 2], a[8 * s2 + 3]); \
                pw.z = cvt_pk_bf16(a[8 * s2 + 4], a[8 * s2 + 5]); pw.w = cvt_pk_bf16(a[8 * s2 + 6], a[8 * s2 + 7]); \
                const bf16x8 pf = __builtin_bit_cast(bf16x8, pw); \
                const int slotA = sb + 16 * s2 + 4 * hi + q4; \
                _Pragma("unroll") for (int dh = 0; dh < 2; ++dh) { \
                    const int colb = (32 * dh + 16 * dc16 + 4 * p4) * 2; \
                    const int addr = VOFF + slotA * 128 + (colb ^ (((slotA >> 1) & 1) << 6)); \
                    const s16x4 lo = __builtin_bit_cast(s16x4, __builtin_amdgcn_ds_read_tr16_b64_v4i16((LAS s16x4*)(lds + addr))); \
                    const s16x4 hh = __builtin_bit_cast(s16x4, __builtin_amdgcn_ds_read_tr16_b64_v4i16((LAS s16x4*)(lds + addr + 1024))); \
                    const bf16x8 vf = (bf16x8){lo[0], lo[1], lo[2], lo[3], hh[0], hh[1], hh[2], hh[3]}; \
                    if (dh == 0) o0 = __builtin_amdgcn_mfma_f32_32x32x16_bf16(vf, pf, o0, 0, 0, 0); \
                    else o1 = __builtin_amdgcn_mfma_f32_32x32x16_bf16(vf, pf, o1, 0, 0, 0); } } \
        } while (0)
        ATT_TILE(4, false, true);
        for (int i = 3; i >= 1 && i >= i0; --i) ATT_TILE(i, false, false);
        if (i0 == 0) ATT_TILE(0, true, false);
#undef ATT_TILE
        lsum += __shfl_xor(lsum, 32);
        const float inv = 1.f / lsum;
#pragma unroll
        for (int rq = 0; rq < 4; ++rq) {
            u32x2 w0; w0.x = cvt_pk_bf16(o0[4 * rq + 0] * inv, o0[4 * rq + 1] * inv); w0.y = cvt_pk_bf16(o0[4 * rq + 2] * inv, o0[4 * rq + 3] * inv);
            u32x2 w1; w1.x = cvt_pk_bf16(o1[4 * rq + 0] * inv, o1[4 * rq + 1] * inv); w1.y = cvt_pk_bf16(o1[4 * rq + 2] * inv, o1[4 * rq + 3] * inv);
            *(u32x2*)(Qw + 8 * rq + 4 * hi) = w0; *(u32x2*)(Qw + 32 + 8 * rq + 4 * hi) = w1;
        }
        if (hi == 0) LSE[((size_t)g * MC + prow0 + 32 * wid + q) * 16 + h] = mx + log2f(lsum);
        __syncthreads();
        u = un;
    }
#undef ATT_DECODE
#undef ATT_ISSUE
}
__device__ __forceinline__ void merge_phase(const Ctx& F0, const bf16_t* Oc, const float* LSE, bf16_t* OM) {
    const Ctx F = relaunder(F0);
    const int gw = F.bid * NWAVES + F.wave, NGW = F.G * NWAVES;
    constexpr size_t MAT = (size_t)MC * 1024;
    const int col = F.lane * 16, h = F.lane >> 2;
    for (int r = gw; r < MC; r += NGW) {
        const int tt = r & 4095, bb = r & ~4095;
        int pr[3]; float l[3];
#pragma unroll
        for (int g = 0; g < 3; ++g) { const int sh = 2 * g; pr[g] = bb + ((tt & ((1 << sh) - 1)) << (12 - sh)) + (tt >> sh); l[g] = LSE[((size_t)g * MC + pr[g]) * 16 + h]; }
        const float mx = fmaxf(l[0], fmaxf(l[1], l[2]));
        float w[3]; w[0] = exp2f(l[0] - mx); w[1] = exp2f(l[1] - mx); w[2] = exp2f(l[2] - mx);
        const float inv = 1.f / (w[0] + w[1] + w[2]);
        float acc[16];
#pragma unroll
        for (int e = 0; e < 16; ++e) acc[e] = 0.f;
#pragma unroll
        for (int g = 0; g < 3; ++g) { const bf16_t* p = Oc + (size_t)g * MAT + ((size_t)h * MC + pr[g]) * 64 + (F.lane & 3) * 16; float f0[8], f1[8]; unpack8(*(const u32x4*)p, f0); unpack8(*(const u32x4*)(p + 8), f1);
            const float wg = w[g] * inv;
#pragma unroll
            for (int e = 0; e < 8; ++e) { acc[e] += wg * f0[e]; acc[8 + e] += wg * f1[e]; } }
        float o0[8], o1[8];
#pragma unroll
        for (int e = 0; e < 8; ++e) { o0[e] = acc[e]; o1[e] = acc[8 + e]; }
        bf16_t* op = OM + (size_t)r * DM + col; *(u32x4*)op = pack8(o0); *(u32x4*)(op + 8) = pack8(o1);
    }
}

#define XB_TMO      128
#define XB_XCNT(j)  (256  + 64 * (j))
#define XB_XSUB(j)  (1280 + 64 * (j))
#define XB_XGEN(j)  (2304 + 64 * (j))
#define XB_TOP      3328
#define XB_TOPGEN   3392
#define XCD_BAR_WORDS 3456
#define XB_SPIN_CAP (1u << 18)
__device__ __forceinline__ unsigned xb_ld(unsigned* p)              { return __hip_atomic_load(p, __ATOMIC_RELAXED, __HIP_MEMORY_SCOPE_AGENT); }
__device__ __forceinline__ unsigned xb_add(unsigned* p, unsigned v) { return __hip_atomic_fetch_add(p, v, __ATOMIC_RELAXED, __HIP_MEMORY_SCOPE_AGENT); }
__device__ __forceinline__ unsigned xb_xcc_id() { return (unsigned)__builtin_amdgcn_s_getreg((3 << 11) | 20) & 0xFu; }
#define XB_SPIN(cond, bar) do { unsigned _sp = 0; while (cond) { __builtin_amdgcn_s_sleep(1); \
    if ((++_sp & 255u) == 0u) { if (xb_ld(&(bar)[XB_TMO])) break; if (_sp > XB_SPIN_CAP) { atomicAdd(&(bar)[XB_TMO], 1u); break; } } } } while (0)
struct XcdBarrier { unsigned* bar; unsigned x; volatile LAS unsigned* st; };
__device__ __forceinline__ XcdBarrier xcd_barrier_post(unsigned* bar, volatile LAS unsigned* st) {
    XcdBarrier b; b.bar = bar; b.x = xb_xcc_id(); b.st = st;
    if (threadIdx.x == 0) (void)xb_add(&bar[XB_XCNT(b.x)], 1u);
    return b;
}
__device__ __forceinline__ void xcd_barrier_complete(unsigned* bar, unsigned x, unsigned& nloc, unsigned& nx) {
    const unsigned G = gridDim.x * gridDim.y * gridDim.z;
    unsigned sum, cnt, mine, sp = 0u;
    for (;;) {
        sum = 0u; cnt = 0u; mine = 0u;
#pragma unroll
        for (unsigned j = 0; j < 16; ++j) { const unsigned c = xb_ld(&bar[XB_XCNT(j)]); sum += c; cnt += (c > 0u) ? 1u : 0u; mine = (j == x) ? c : mine; }
        if (sum == G) break;
        __builtin_amdgcn_s_sleep(1);
        if ((++sp & 255u) == 0u) { if (xb_ld(&bar[XB_TMO])) break; if (sp > XB_SPIN_CAP) { atomicAdd(&bar[XB_TMO], 1u); break; } }
    }
    nloc = mine > 0u ? mine : 1u; nx = cnt > 0u ? cnt : 1u;
}
__device__ __forceinline__ void xcd_barrier(const XcdBarrier& b) {
    asm volatile("s_waitcnt vmcnt(0)" ::: "memory");
    __syncthreads();
    int t0_ = threadIdx.x; asm volatile("" : "+v"(t0_));
    if (t0_ == 0) {
        unsigned* bar = b.bar; unsigned bx = b.x; asm volatile("" : "+s"(bx));
        __builtin_amdgcn_s_waitcnt(0);
        unsigned nloc = b.st[0], nx = b.st[1];
        if (nloc == 0u) { xcd_barrier_complete(bar, bx, nloc, nx); b.st[0] = nloc; b.st[1] = nx; }
        const unsigned old = xb_add(&bar[XB_XSUB(bx)], 1u);
        const unsigned gen = old / nloc;
        if (old + 1u == (gen + 1u) * nloc) {
            __builtin_amdgcn_fence(__ATOMIC_RELEASE, "agent");
            asm volatile("s_waitcnt vmcnt(0)" ::: "memory");
            const unsigned og = xb_add(&bar[XB_TOP], 1u);
            const unsigned tg = og / nx;
            if (og + 1u == (tg + 1u) * nx) xb_add(&bar[XB_TOPGEN], 1u);
            else XB_SPIN(xb_ld(&bar[XB_TOPGEN]) == tg, bar);
            __builtin_amdgcn_fence(__ATOMIC_ACQUIRE, "agent");
            xb_add(&bar[XB_XGEN(bx)], 1u);
            asm volatile("s_waitcnt vmcnt(0)" ::: "memory");
        } else {
            XB_SPIN(xb_ld(&bar[XB_XGEN(bx)]) == gen, bar);
            __builtin_amdgcn_fence(__ATOMIC_ACQUIRE, "agent");
            asm volatile("s_waitcnt vmcnt(0)" ::: "memory");
        }
    }
    __syncthreads();
}

struct Args { const float* in[21]; float* out; unsigned char* ws; };
enum { I_X = 0, I_C, I_ADAW, I_ADAB, I_N1G, I_N2G, I_PWIN, I_PWGRP, I_PSCALE, I_PWOUT, I_KVNG, I_KVADAW, I_KVADAB, I_WKV, I_WQ, I_WO, I_WUP, I_CONVW, I_CONVB, I_WDN, I_FING };

__global__ void __launch_bounds__(NTHREADS, 2) mega_fwd(Args a) {
    extern __shared__ __attribute__((aligned(16))) unsigned char lds_raw[];
    cg::grid_group grid = cg::this_grid();
    Ctx F; F.lds = (LAS unsigned char*)lds_raw; F.tid = threadIdx.x; F.lane = F.tid & 63; F.wave = __builtin_amdgcn_readfirstlane(F.tid >> 6); F.bid = blockIdx.x; F.G = gridDim.x;
    unsigned char* ws = a.ws;
    float* mod = (float*)(ws + WS_MOD); float* kvmod = (float*)(ws + WS_KVMOD);
    bf16_t* X = (bf16_t*)((unsigned char*)a.out + 64 * MiB);
    float* halo = (float*)(ws + WS_HALO); float* raw0 = (float*)(ws + WS_RAW0);
    LAS float* xch = (LAS float*)(F.lds + 131072 + 4096);
#define GSYNC_CG() do { asm volatile("s_waitcnt vmcnt(0)" ::: "memory"); grid.sync(); __builtin_amdgcn_fence(__ATOMIC_ACQUIRE, "agent"); } while (0)
#define GSYNC() xcd_barrier(bar)
    volatile LAS unsigned* MISC = (volatile LAS unsigned*)(F.lds + 131072 + 320);
    if (F.tid < 32) MISC[F.tid] = 0u;
    unsigned* barw = (unsigned*)(ws + WS_BAR);
    __syncthreads();

    for (int L = 0; L < 2; ++L) {
        transpose_matrix(F, a.in[I_PWIN] + (size_t)L * DM * DM, DM, DM, (bf16_t*)(ws + WA_WIN) + (size_t)L * DM * DM, 0);
        transpose_matrix<true>(F, a.in[I_WUP] + (size_t)L * DM * NUP, DM, NUP, (bf16_t*)(ws + WA_WUP) + (size_t)L * DM * NUP, 0);
        transpose_matrix(F, a.in[I_WDN] + (size_t)L * FF * DM, FF, DM, (bf16_t*)(ws + WA_WDN) + (size_t)L * FF * DM, 0);
    }
    fold_pool_weights(F, a.in[I_PWGRP], a.in[I_PSCALE], a.in[I_PWOUT], (bf16_t*)(ws + WA_WOUT));
    mod_phase(F, a.in[I_C], a.in[I_ADAW], a.in[I_ADAB], a.in[I_KVADAW], a.in[I_KVADAB], mod, kvmod);
    const XcdBarrier bar = xcd_barrier_post(barw, MISC + 8);
    if (a.ws == nullptr) GSYNC_CG();
    GSYNC();

    for (int L = 0; L < 2; ++L) {
        const float* modL = mod + (size_t)L * 8 * 6144;
        bf16_t* H = (bf16_t*)(ws + WA_H); bf16_t* U = (bf16_t*)(ws + WA_U); bf16_t* PB = (bf16_t*)(ws + WA_PB); bf16_t* AV = (bf16_t*)(ws + WA_AV);
        if (L == 0) norm_phase<false>(F, a.in[I_X], H, a.in[I_N1G] + L * DM, modL + 0, modL + 1024, 6144, 0, MTOT);
        else norm_phase<true>(F, X, H, a.in[I_N1G] + L * DM, modL + 0, modL + 1024, 6144, 0, MTOT);
        GSYNC();
        { pg8::Gemm g{H, (bf16_t*)(ws + WA_WIN) + (size_t)L * DM * DM, MTOT, DM, DM, DM, DM, 0}; pg8::StaticOrder S; S.init(MTOT, DM, F.G, F.bid);
          pg8::EpiBf16 E{U, DM, nullptr}; pg8::gemm_phase(F.lds, g, S, E); }
        GSYNC();
        pool_phase(F, U, PB);
        GSYNC();
        { pg8::Gemm g{PB, (bf16_t*)(ws + WA_WOUT) + (size_t)L * DM * DM, MTOT, DM, DM, DM, DM, 0}; pg8::StaticOrder S; S.init(MTOT, DM, F.G, F.bid);
          if (L == 0) { pg8::EpiResid<true> E{a.in[I_X], nullptr, X, modL + 2048, 0}; pg8::gemm_phase(F.lds, g, S, E); }
          else { pg8::EpiResid<false> E{nullptr, X, X, modL + 2048, 0}; pg8::gemm_phase(F.lds, g, S, E); } }
        GSYNC();
        norm_phase<true>(F, X, H, a.in[I_N2G] + L * DM, modL + 3072, modL + 4096, 6144, 0, MTOT);
        GSYNC();
        { pg8::Gemm g{H, (bf16_t*)(ws + WA_WUP) + (size_t)L * DM * NUP, MTOT, NUP, DM, DM, DM, 0}; pg8::StaticOrder S; S.init(MTOT, NUP, F.G, F.bid);
          pg8::EpiConvGate E{AV, a.in[I_CONVW] + (size_t)L * 3 * FF, a.in[I_CONVB] + (size_t)L * FF, halo, raw0, xch}; pg8::gemm_phase(F.lds, g, S, E); }
        GSYNC();
        { pg8::Gemm g{AV, (bf16_t*)(ws + WA_WDN) + (size_t)L * FF * DM, MTOT, DM, FF, FF, FF, 0}; pg8::StaticOrder S; S.init(MTOT, DM, F.G, F.bid);
          conv_fix_units(F, S, AV, a.in[I_CONVW] + (size_t)L * 3 * FF, a.in[I_CONVB] + (size_t)L * FF, halo, raw0, 0);
          pg8::EpiResid<false> E{nullptr, X, X, modL + 5120, 0}; pg8::gemm_phase(F.lds, g, S, E); }
        GSYNC();
    }

    transpose_matrix(F, a.in[I_WKV], DM, 6144, (bf16_t*)(ws + WB_WKV), 0);
    for (int j = 0; j < 2; ++j) {
        transpose_matrix(F, a.in[I_WQ] + (size_t)j * DM * 3072, DM, 3072, (bf16_t*)(ws + WB_WQ) + (size_t)j * DM * 3072, 0);
        transpose_matrix(F, a.in[I_WO] + (size_t)j * DM * DM, DM, DM, (bf16_t*)(ws + WB_WO) + (size_t)j * DM * DM, 0);
        transpose_matrix<true>(F, a.in[I_WUP] + (size_t)(2 + j) * DM * NUP, DM, NUP, (bf16_t*)(ws + WB_WUP) + (size_t)j * DM * NUP, 0);
        transpose_matrix(F, a.in[I_WDN] + (size_t)(2 + j) * FF * DM, FF, DM, (bf16_t*)(ws + WB_WDN) + (size_t)j * FF * DM, 0);
    }
    __syncthreads();

    for (int c = 0; c < 2; ++c) {
        const int row0 = c * MC;
        bf16_t* H = (bf16_t*)(ws + WB_H); bf16_t* KVc = (bf16_t*)(ws + WB_KV); bf16_t* Qc = (bf16_t*)(ws + WB_Q); bf16_t* AV = (bf16_t*)(ws + WB_AV); float* LSE = (float*)(ws + WB_LSE);
        bf16_t* H2 = (bf16_t*)(ws + WB_H2);
        { const float* mod2 = mod + (size_t)2 * 8 * 6144;
          norm_dual_phase(F, X, H, a.in[I_KVNG], kvmod + 0, kvmod + 1024, 2048, H2, a.in[I_N1G] + 2 * DM, mod2 + 0, mod2 + 1024, 6144, row0, MC); }
        GSYNC();
        { pg8::Gemm g{H, (bf16_t*)(ws + WB_WKV), MC, 6144, DM, DM, DM, 0}; pg8::StaticOrder S; S.init(MC, 6144, F.G, F.bid);
          pg8::EpiQKV E{KVc, (size_t)MC * 1024, 1.0f}; pg8::gemm_phase(F.lds, g, S, E); }
        { pg8::Gemm g{H2, (bf16_t*)(ws + WB_WQ), MC, 3072, DM, DM, DM, 0}; pg8::StaticOrder S; S.init(MC, 3072, F.G, F.bid);
          pg8::EpiQKV E{Qc, (size_t)MC * 1024, 0.125f * LOG2E}; pg8::gemm_phase(F.lds, g, S, E); }
        GSYNC();
        for (int j = 0; j < 2; ++j) {
            const int L = 2 + j; const float* modL = mod + (size_t)L * 8 * 6144;
            if (j == 1) {
                norm_phase<true>(F, X, H, a.in[I_N1G] + L * DM, modL + 0, modL + 1024, 6144, row0, MC);
                GSYNC();
                { pg8::Gemm g{H, (bf16_t*)(ws + WB_WQ) + (size_t)j * DM * 3072, MC, 3072, DM, DM, DM, 0}; pg8::StaticOrder S; S.init(MC, 3072, F.G, F.bid);
                  pg8::EpiQKV E{Qc, (size_t)MC * 1024, 0.125f * LOG2E}; pg8::gemm_phase(F.lds, g, S, E); }
                GSYNC();
            }
            attn_phase(F, Qc, KVc, LSE);
            GSYNC();
            merge_phase(F, Qc, LSE, H);
            GSYNC();
            { pg8::Gemm g{H, (bf16_t*)(ws + WB_WO) + (size_t)j * DM * DM, MC, DM, DM, DM, DM, 0}; pg8::StaticOrder S; S.init(MC, DM, F.G, F.bid);
              pg8::EpiResid<false> E{nullptr, X, X, modL + 2048, row0}; pg8::gemm_phase(F.lds, g, S, E); }
            GSYNC();
            norm_phase<true>(F, X, H, a.in[I_N2G] + L * DM, modL + 3072, modL + 4096, 6144, row0, MC);
            GSYNC();
            { pg8::Gemm g{H, (bf16_t*)(ws + WB_WUP) + (size_t)j * DM * NUP, MC, NUP, DM, DM, DM, 0}; pg8::StaticOrder S; S.init(MC, NUP, F.G, F.bid);
              pg8::EpiConvGate E{AV, a.in[I_CONVW] + (size_t)L * 3 * FF, a.in[I_CONVB] + (size_t)L * FF, halo, raw0, xch}; pg8::gemm_phase(F.lds, g, S, E); }
            GSYNC();
            { pg8::Gemm g{AV, (bf16_t*)(ws + WB_WDN) + (size_t)j * FF * DM, MC, DM, FF, FF, FF, 0}; pg8::StaticOrder S; S.init(MC, DM, F.G, F.bid);
              conv_fix_units(F, S, AV, a.in[I_CONVW] + (size_t)L * 3 * FF, a.in[I_CONVB] + (size_t)L * FF, halo, raw0, row0);
              bf16_t* Xo = (c == 1 && j == 1) ? (bf16_t*)(ws + WS_XTAIL) - (size_t)MC * DM : X;
              pg8::EpiResid<false> E{nullptr, X, Xo, modL + 5120, row0}; pg8::gemm_phase(F.lds, g, S, E); }
            GSYNC();
        }
    }
    final_norm_phase(F, X, 0, a.out, a.in[I_FING], 0, MC);
    GSYNC();
    final_norm_phase(F, (const bf16_t*)(ws + WS_XTAIL), MC, a.out, a.in[I_FING], MC, MTOT);
}

extern "C" void kernel_launch(void* const* d_in, const int* in_sizes, int n_in, void* d_out, int out_size, void* d_ws, size_t ws_size, hipStream_t stream) {
    static int grid = 0;
    if (grid == 0) {
        int dev = 0, cus = 0, per_cu = 0;
        if (n_in != 21 || out_size != MTOT * DM || ws_size < 512 * MiB) { fprintf(stderr, "kernel_launch: unexpected problem (n_in %d, out %d, ws %zu)\n", n_in, out_size, ws_size); grid = -1; return; }
        if (hipGetDevice(&dev) != hipSuccess || hipDeviceGetAttribute(&cus, hipDeviceAttributeMultiprocessorCount, dev) != hipSuccess) { grid = -1; return; }
        if (hipFuncSetAttribute((const void*)mega_fwd, hipFuncAttributeMaxDynamicSharedMemorySize, LDS_BYTES) != hipSuccess) { fprintf(stderr, "kernel_launch: hipFuncSetAttribute failed\n"); grid = -1; return; }
        if (hipOccupancyMaxActiveBlocksPerMultiprocessor(&per_cu, (const void*)mega_fwd, NTHREADS, LDS_BYTES) != hipSuccess || per_cu < 1) { fprintf(stderr, "kernel_launch: occupancy query says %d\n", per_cu); per_cu = 1; }
        (void)hipGetLastError();
        grid = cus;
    }
    if (grid < 0) return;
    Args a{};
    for (int i = 0; i < 21; ++i) a.in[i] = (const float*)d_in[i];
    a.out = (float*)d_out; a.ws = (unsigned char*)d_ws;
    if (hipMemsetAsync((unsigned char*)d_ws + WS_BAR, 0, XCD_BAR_WORDS * 4, stream) != hipSuccess) { fprintf(stderr, "kernel_launch: memset of the barrier words failed\n"); return; }
    void* args[] = {&a};
    hipError_t e = hipLaunchCooperativeKernel((const void*)mega_fwd, dim3(grid), dim3(NTHREADS), args, LDS_BYTES, stream);
    if (e != hipSuccess) fprintf(stderr, "kernel_launch: cooperative launch failed: %s (grid %d)\n", hipGetErrorString(e), grid);
}
```

```cpp
#include <hip/hip_runtime.h>
#include <hip/hip_cooperative_groups.h>
#include <cstdio>
#include <cstdint>
#include <cmath>
namespace cg = cooperative_groups;

#define LAS __attribute__((address_space(3)))
typedef unsigned short bf16_t;
typedef short bf16x8 __attribute__((ext_vector_type(8)));
typedef short s16x4 __attribute__((ext_vector_type(4)));
typedef float f32x4 __attribute__((ext_vector_type(4)));
typedef float f32x16 __attribute__((ext_vector_type(16)));
typedef unsigned u32x4 __attribute__((ext_vector_type(4)));
typedef unsigned u32x2 __attribute__((ext_vector_type(2)));

constexpr int SEQ = 4096, DM = 1024, NB = 8, MTOT = NB * SEQ, FF = 2816, NUP = 2 * FF, DEPTH = 4;
constexpr int MC = 16384;
constexpr float EPS = 1e-6f;
constexpr float LOG2E = 1.4426950408889634f;
constexpr int NTHREADS = 512, NWAVES = 8;
constexpr int LDS_BYTES = 147456;

constexpr size_t MiB = 1u << 20;
constexpr size_t WS_MOD = 0;
constexpr size_t WS_KVMOD = 4 * 8 * 6144 * 4;
constexpr size_t WS_BAR = 896 * 1024;
constexpr size_t WA_WIN = 1 * MiB;
constexpr size_t WA_WGRP = 5 * MiB;
constexpr size_t WA_WOUT = 6 * MiB;
constexpr size_t WA_WUP = 10 * MiB;
constexpr size_t WA_WDN = 32 * MiB;
constexpr size_t WA_H = 44 * MiB;
constexpr size_t WA_AV = 108 * MiB;
constexpr size_t WA_U = 108 * MiB, WA_PB = 172 * MiB, WA_Y = 236 * MiB;
constexpr size_t WB_WKV = 1 * MiB;
constexpr size_t WB_WQ = 13 * MiB;
constexpr size_t WB_WO = 25 * MiB;
constexpr size_t WB_WUP = 29 * MiB;
constexpr size_t WB_WDN = 51 * MiB;
constexpr size_t WB_H = 62 * MiB;
constexpr size_t WB_LSE = 94 * MiB;
constexpr size_t WB_KV = 97 * MiB;
constexpr size_t WB_Q = 289 * MiB;
constexpr size_t WB_AV = 289 * MiB;
constexpr size_t WB_H2 = 480 * MiB;
constexpr size_t WS_XTAIL = 128 * MiB;
constexpr size_t WS_HALO = 470 * MiB;
constexpr size_t WS_RAW0 = 474 * MiB;

__device__ __forceinline__ unsigned f2bf(float f) { unsigned u = __builtin_bit_cast(unsigned, f); return (u + 0x7fffu + ((u >> 16) & 1u)) >> 16; }
__device__ __forceinline__ unsigned cvt_pk_bf16(float lo, float hi) { unsigned r; asm volatile("v_cvt_pk_bf16_f32 %0, %1, %2" : "=v"(r) : "v"(lo), "v"(hi)); return r; }
__device__ __forceinline__ unsigned pk2(float lo, float hi) { unsigned r; asm("v_cvt_pk_bf16_f32 %0, %1, %2" : "=v"(r) : "v"(lo), "v"(hi)); return r; }
__device__ __forceinline__ float bflo(unsigned w) { return __builtin_bit_cast(float, w << 16); }
__device__ __forceinline__ float bfhi(unsigned w) { return __builtin_bit_cast(float, w & 0xffff0000u); }
__device__ __forceinline__ float wave_sum(float v) {
#pragma unroll
    for (int o = 1; o < 64; o <<= 1) v += __shfl_xor(v, o);
    return v;
}
#define LDS_WAIT() asm volatile("s_waitcnt lgkmcnt(0)" ::: "memory")

namespace pg8 {
constexpr int BM = 256, BK = 64, HALF = 128, HTB = HALF * BK * 2, STAGE_BYTES = 8 * HTB, NXCD = 8, WGM = 8;
__host__ __device__ __forceinline__ int lds_byte(int r, int c) { const int st = (r >> 4) * 2 + (c >> 5), rr = r & 15, cc = c & 31, ob = rr * 64 + cc * 2; return st * 1024 + (ob ^ (((ob >> 9) & 1) << 5)); }
__host__ __device__ __forceinline__ void stage_rc(int b, int& R, int& C) { const int st = b / 1024, sb = b % 1024, swz = sb ^ (((sb >> 9) & 1) << 5); R = (st >> 1) * 16 + swz / 64; C = (st & 1) * 32 + (swz % 64) / 2; }
__host__ __device__ __forceinline__ int perm32(int rho) { const int n = rho >> 4, i = rho & 15; return 8 * (i >> 2) + 4 * n + (i & 3); }

struct Unit { int pm, pn; };
struct Gemm { const bf16_t* A; const bf16_t* Bt; int M, N, K, lda, ldb, a_pn_koff; };

struct StaticOrder {
    int nM, nN, nwg, G, c;
    __device__ void init(int M, int N, int G_, int c_) { nM = M / BM; nN = N / BM; nwg = nM * nN; G = G_; c = c_; }
    __device__ bool next(int i, Unit& u) const {
        const long L = (long)i * G + c; if (L >= nwg) return false;
        int wgid = (int)L; { const int q = nwg / NXCD, r = nwg % NXCD, xcd = wgid % NXCD, off = wgid / NXCD; wgid = (xcd < r ? xcd * (q + 1) : r * (q + 1) + (xcd - r) * q) + off; }
        const int nig = WGM * nN, gid = wgid / nig, fm = gid * WGM, gsz = (nM - fm) < WGM ? (nM - fm) : WGM;
        u.pm = fm + ((wgid % nig) % gsz); u.pn = (wgid % nig) / gsz; return true;
    }
};

struct EpiBf16 {
    static constexpr bool PERM = true;
    bf16_t* O; int ldc; const float* cscale;
    __device__ __forceinline__ void operator()(const f32x4 (&acc)[2][2][4][2], const Unit& u, int wr, int wc, int fr, int fq) const {
        const int row0 = u.pm * BM + wr * 64 + fr; const int col0 = u.pn * BM + wc * 32 + 8 * fq;
        f32x4 sv[2][2];
#pragma unroll
        for (int bj = 0; bj < 2; ++bj)
#pragma unroll
            for (int n = 0; n < 2; ++n) sv[bj][n] = cscale ? *(const f32x4*)(cscale + col0 + bj * HALF + 4 * n) : (f32x4){1.f, 1.f, 1.f, 1.f};
#pragma unroll
        for (int ai = 0; ai < 2; ++ai)
#pragma unroll
            for (int m = 0; m < 4; ++m) { bf16_t* rowp = O + (size_t)(row0 + ai * HALF + m * 16) * ldc + col0;
#pragma unroll
                for (int bj = 0; bj < 2; ++bj) { const f32x4 v0 = acc[ai][bj][m][0] * sv[bj][0], v1 = acc[ai][bj][m][1] * sv[bj][1];
                    u32x4 w; w.x = cvt_pk_bf16(v0[0], v0[1]); w.y = cvt_pk_bf16(v0[2], v0[3]); w.z = cvt_pk_bf16(v1[0], v1[1]); w.w = cvt_pk_bf16(v1[2], v1[3]);
                    *(u32x4*)(rowp + bj * HALF) = w; } }
    }
};
struct EpiQKV {
    static constexpr bool PERM = true;
    bf16_t* O; size_t mat_stride; float scale;
    __device__ __forceinline__ void operator()(const f32x4 (&acc)[2][2][4][2], const Unit& u, int wr, int wc, int fr, int fq) const {
        const int colt = u.pn * BM; const int t = colt >> 10; const int g = t % 3; const int sh = 2 * g; const int dm1 = (1 << sh) - 1;
        const int hd0 = ((colt & 1023) >> 6) + (wc >> 1);
        bf16_t* base = O + (size_t)t * mat_stride + (size_t)hd0 * MC * 64 + (wc & 1) * 32 + 8 * fq;
        const int row0 = u.pm * BM + wr * 64 + fr;
#pragma unroll
        for (int ai = 0; ai < 2; ++ai)
#pragma unroll
            for (int m = 0; m < 4; ++m) { const int r = row0 + ai * HALF + m * 16; const int tt = r & 4095;
                const int dest = (r & ~4095) + ((tt & dm1) << (12 - sh)) + (tt >> sh);
                bf16_t* rowp = base + (size_t)dest * 64;
#pragma unroll
                for (int bj = 0; bj < 2; ++bj) { const f32x4 v0 = acc[ai][bj][m][0] * scale, v1 = acc[ai][bj][m][1] * scale;
                    u32x4 w; w.x = cvt_pk_bf16(v0[0], v0[1]); w.y = cvt_pk_bf16(v0[2], v0[3]); w.z = cvt_pk_bf16(v1[0], v1[1]); w.w = cvt_pk_bf16(v1[2], v1[3]);
                    *(u32x4*)(rowp + (size_t)bj * 2 * MC * 64) = w; } }
    }
};
template <bool BASE_F32>
struct EpiResid {
    static constexpr bool PERM = true;
    const float* base32; const bf16_t* base16; bf16_t* out; const float* gate; int row_base;
    __device__ __forceinline__ void operator()(const f32x4 (&acc)[2][2][4][2], const Unit& u, int wr, int wc, int fr, int fq) const {
        const int rowt = row_base + u.pm * BM; const int b = rowt >> 12;
        const int col0 = u.pn * BM + wc * 32 + 8 * fq; const int row0 = rowt + wr * 64 + fr;
        f32x4 gv[2][2];
#pragma unroll
        for (int bj = 0; bj < 2; ++bj)
#pragma unroll
            for (int n = 0; n < 2; ++n) gv[bj][n] = *(const f32x4*)(gate + (size_t)b * 6144 + col0 + bj * HALF + 4 * n);
        constexpr int NG = BASE_F32 ? 2 : 4;
#pragma unroll
        for (int rd = 0; rd < 8 / NG; ++rd) {
            u32x4 bw[NG][2]; f32x4 bf[BASE_F32 ? NG : 1][2][2];
#pragma unroll
            for (int mi = 0; mi < NG; ++mi) { const int gi = rd * NG + mi, ai = gi >> 2, m = gi & 3; const size_t off = (size_t)(row0 + ai * HALF + m * 16) * DM + col0;
#pragma unroll
                for (int bj = 0; bj < 2; ++bj) {
                    if (BASE_F32) { bf[BASE_F32 ? mi : 0][bj][0] = *(const f32x4*)(base32 + off + bj * HALF); bf[BASE_F32 ? mi : 0][bj][1] = *(const f32x4*)(base32 + off + bj * HALF + 4); }
                    else bw[mi][bj] = *(const u32x4*)(base16 + off + bj * HALF); } }
            asm volatile("" ::: "memory");
#pragma unroll
            for (int mi = 0; mi < NG; ++mi) { const int gi = rd * NG + mi, ai = gi >> 2, m = gi & 3; const size_t off = (size_t)(row0 + ai * HALF + m * 16) * DM + col0;
#pragma unroll
                for (int bj = 0; bj < 2; ++bj) {
                    f32x4 b0, b1;
                    if (BASE_F32) { b0 = bf[BASE_F32 ? mi : 0][bj][0]; b1 = bf[BASE_F32 ? mi : 0][bj][1]; }
                    else { const u32x4 w = bw[mi][bj]; b0 = (f32x4){bflo(w.x), bfhi(w.x), bflo(w.y), bfhi(w.y)}; b1 = (f32x4){bflo(w.z), bfhi(w.z), bflo(w.w), bfhi(w.w)}; }
                    const f32x4 v0 = b0 + gv[bj][0] * acc[ai][bj][m][0], v1 = b1 + gv[bj][1] * acc[ai][bj][m][1];
                    u32x4 w; w.x = cvt_pk_bf16(v0[0], v0[1]); w.y = cvt_pk_bf16(v0[2], v0[3]); w.z = cvt_pk_bf16(v1[0], v1[1]); w.w = cvt_pk_bf16(v1[2], v1[3]);
                    *(u32x4*)(out + off + bj * HALF) = w; } }
            asm volatile("" ::: "memory");
        }
    }
};

struct EpiConvGate {
    static constexpr bool PERM = true;
    bf16_t* G; const float* cw; const float* cb; float* halo; float* raw0; LAS float* xch;
    __device__ __forceinline__ void operator()(const f32x4 (&acc)[2][2][4][2], const Unit& u, int wr, int wc, int fr, int fq) const {
        const int lane = threadIdx.x & 63;
        const int colh = u.pn * 128 + wc * 32 + 8 * fq;
#define EA(ai, m, e) acc[ai][0][m][(e) >> 2][(e) & 3]
#define EV(ai, m, e) acc[ai][1][m][(e) >> 2][(e) & 3]
        if (fr >= 14) {
#pragma unroll
            for (int ai = 0; ai < 2; ++ai) { LAS float* xp = xch + ((((ai * 2 + wr) * 4 + wc) * 2 + (fr - 14)) * 4 + fq) * 8;
                *(LAS f32x4*)xp = acc[ai][0][3][0]; *(LAS f32x4*)(xp + 4) = acc[ai][0][3][1]; }
            if (wr == 1) { float* hp = halo + ((size_t)u.pm * 2 + (fr - 14)) * FF + colh; *(f32x4*)hp = acc[1][0][3][0]; *(f32x4*)(hp + 4) = acc[1][0][3][1]; }
        }
        asm volatile("s_waitcnt lgkmcnt(0)" ::: "memory"); __builtin_amdgcn_s_barrier(); asm volatile("" ::: "memory");
        f32x4 w0[2], w1[2], w2[2], bb[2];
#pragma unroll
        for (int nh = 0; nh < 2; ++nh) { const int colq = colh + 4 * nh; w0[nh] = *(const f32x4*)(cw + colq); w1[nh] = *(const f32x4*)(cw + FF + colq); w2[nh] = *(const f32x4*)(cw + 2 * FF + colq); bb[nh] = *(const f32x4*)(cb + colq); }
#pragma unroll
        for (int ai = 0; ai < 2; ++ai) {
            f32x4 q1[2], q2[2];
            const bool seam = (ai == 0 && wr == 0);
            if (!seam) { const int pai = wr == 1 ? ai : 0, pwr = wr == 1 ? 0 : 1; const LAS float* xp = xch + ((((pai * 2 + pwr) * 4 + wc) * 2) * 4 + fq) * 8;
#pragma unroll
                for (int nh = 0; nh < 2; ++nh) { const f32x4 p14 = *(const LAS f32x4*)(xp + 4 * nh), p15 = *(const LAS f32x4*)(xp + 32 + 4 * nh); q1[nh] = p15; q2[nh] = (fr == 1) ? p15 : p14; } }
            else { q1[0] = (f32x4){0.f, 0.f, 0.f, 0.f}; q1[1] = q1[0]; q2[0] = q1[0]; q2[1] = q1[0]; }
#pragma unroll
            for (int m = 0; m < 4; ++m) {
                u32x4 wout;
#pragma unroll
                for (int nh = 0; nh < 2; ++nh) {
                    const f32x4 av = acc[ai][0][m][nh], vv = acc[ai][1][m][nh];
                    f32x4 o;
#pragma unroll
                    for (int e = 0; e < 4; ++e) {
                        const float ac = av[e];
                        const float c1 = __builtin_bit_cast(float, __builtin_amdgcn_mov_dpp(__builtin_bit_cast(int, ac), 0x121, 0xF, 0xF, true));
                        const float c2 = __builtin_bit_cast(float, __builtin_amdgcn_mov_dpp(__builtin_bit_cast(int, ac), 0x122, 0xF, 0xF, true));
                        const float pr1 = fr >= 1 ? c1 : q1[nh][e];
                        const float pr2 = fr >= 2 ? c2 : q2[nh][e];
                        const float y = __builtin_fmaf(w2[nh][e], ac, __builtin_fmaf(w1[nh][e], pr1, __builtin_fmaf(w0[nh][e], pr2, bb[nh][e])));
                        o[e] = y * __builtin_amdgcn_rcpf(1.f + __builtin_amdgcn_exp2f(-LOG2E * y)) * vv[e];
                        q1[nh][e] = c1; q2[nh][e] = c2;
                    }
                    if (nh == 0) { wout.x = cvt_pk_bf16(o[0], o[1]); wout.y = cvt_pk_bf16(o[2], o[3]); } else { wout.z = cvt_pk_bf16(o[0], o[1]); wout.w = cvt_pk_bf16(o[2], o[3]); }
                }
                const int trow = ai * HALF + wr * 64 + m * 16 + fr;
                if (seam && m == 0 && fr < 2) {
                    float* rp = raw0 + ((size_t)u.pm * 2 + fr) * NUP + colh;
                    *(f32x4*)rp = acc[0][0][0][0]; *(f32x4*)(rp + 4) = acc[0][0][0][1]; *(f32x4*)(rp + FF) = acc[0][1][0][0]; *(f32x4*)(rp + FF + 4) = acc[0][1][0][1];
                } else *(u32x4*)(G + (size_t)(u.pm * BM + trow) * FF + colh) = wout;
            }
        }
#undef EA
#undef EV
    }
};

template <class Epi, class Sched>
__device__ __forceinline__ void gemm_phase(LAS unsigned char* lds, const Gemm g, const Sched& S, const Epi& E) {
    int tid_ = threadIdx.x; asm volatile("" : "+v"(tid_));
    const int tid = tid_, wid = __builtin_amdgcn_readfirstlane(tid >> 6), lane = tid & 63, wr = wid >> 2, wc = wid & 3, fr = lane & 15, fq = lane >> 4;
    const int K = g.K, nt = K / BK;
    unsigned voffA[2], voffB[2];
#pragma unroll
    for (int i = 0; i < 2; ++i) { int R, C; stage_rc(tid * 16 + i * 8192, R, C); const int Rb = Epi::PERM ? ((R & ~31) + perm32(R & 31)) : R;
        voffA[i] = (unsigned)(R * g.lda + C) * 2u; voffB[i] = (unsigned)(Rb * g.ldb + C) * 2u; }
    const size_t kstep = (size_t)(BK * 2);
    const size_t hstepA = (size_t)HALF * g.lda * 2, hstepB = (size_t)HALF * g.ldb * 2;
    const size_t tstepA = 2 * hstepA, tstepB = 2 * hstepB;
    const unsigned ldsw = (unsigned)wid * 1024u;
    const int aoff = lds_byte(wr * 64 + fr, fq * 8), boff = lds_byte(wc * 32 + fr, fq * 8);
#define PG8_SA(b, h) (((b) * 2 + (h)) * HTB)
#define PG8_SB(b, h) ((4 + (b) * 2 + (h)) * HTB)
#define PG8_STAGE(bufoff, gbase, voff) do { _Pragma("unroll") for (int _i = 0; _i < 2; ++_i) \
        __builtin_amdgcn_global_load_lds((const unsigned*)((const char*)(gbase) + (voff)[_i]), (LAS unsigned*)(lds + (bufoff) + ldsw + _i * 8192), 16, 0, 0); } while (0)
#define PG8_LDA(dst, b, h) do { _Pragma("unroll") for (int m = 0; m < 4; ++m) _Pragma("unroll") for (int k = 0; k < 2; ++k) dst[m][k] = *(const LAS bf16x8*)(lds + PG8_SA(b, h) + aoff + m * 2048 + k * 1024); } while (0)
#define PG8_LDB(dst, b, h) do { _Pragma("unroll") for (int n = 0; n < 2; ++n) _Pragma("unroll") for (int k = 0; k < 2; ++k) dst[n][k] = *(const LAS bf16x8*)(lds + PG8_SB(b, h) + boff + n * 2048 + k * 1024); } while (0)
#define PG8_MMA(ai, bj, At, Bt) do { __builtin_amdgcn_s_setprio(3); _Pragma("unroll") for (int m = 0; m < 4; ++m) _Pragma("unroll") for (int n = 0; n < 2; ++n) _Pragma("unroll") for (int k = 0; k < 2; ++k) \
        acc[ai][bj][m][n] = __builtin_amdgcn_mfma_f32_16x16x32_bf16(Bt[n][k], At[m][k], acc[ai][bj][m][n], 0, 0, 0); __builtin_amdgcn_s_setprio(0); } while (0)
#define PG8_WAIT_V(n) asm volatile("s_waitcnt vmcnt(" #n ")" ::: "memory")
#define PG8_WAIT_L(n) asm volatile("s_waitcnt lgkmcnt(" #n ")" ::: "memory")
#define PG8_BAR __builtin_amdgcn_s_barrier()
#define PG8_SCHED __builtin_amdgcn_sched_barrier(0)
#define PG8_BASEA(un) ((const char*)g.A + (size_t)(un).pm * tstepA + (size_t)(un).pn * (size_t)g.a_pn_koff * 2)
#define PG8_BASEB(un) ((const char*)g.Bt + (size_t)(un).pn * tstepB)
    Unit cur, nxt; int ui = 0;
    if (!S.next(0, cur)) return;
    f32x4 acc[2][2][4][2];
#pragma unroll
    for (int a = 0; a < 2; ++a)
#pragma unroll
        for (int b = 0; b < 2; ++b)
#pragma unroll
            for (int m = 0; m < 4; ++m)
#pragma unroll
                for (int n = 0; n < 2; ++n) acc[a][b][m][n] = (f32x4){0.f, 0.f, 0.f, 0.f};
    bf16x8 At[4][2], B0[2][2], B1[2][2];
    const char* cA = PG8_BASEA(cur); const char* cB = PG8_BASEB(cur);
    PG8_STAGE(PG8_SB(0, 0), cB, voffB); PG8_STAGE(PG8_SB(0, 1), cB + hstepB, voffB); PG8_STAGE(PG8_SA(0, 0), cA, voffA); PG8_STAGE(PG8_SA(0, 1), cA + hstepA, voffA);
    if (wr == 1) PG8_BAR;
    PG8_WAIT_V(2); PG8_BAR;
    PG8_STAGE(PG8_SB(1, 0), cB + kstep, voffB); PG8_STAGE(PG8_SA(1, 0), cA + kstep, voffA); PG8_STAGE(PG8_SB(1, 1), cB + hstepB + kstep, voffB);
    PG8_WAIT_V(6); PG8_BAR;
    for (;;) {
        const bool has_next = S.next(ui + 1, nxt);
        const char* nA = has_next ? PG8_BASEA(nxt) : cA; const char* nB = has_next ? PG8_BASEB(nxt) : cB;
        for (int t = 0; t < nt; t += 2) {
            const bool last = (t == nt - 2);
            const char* a1 = cA + (size_t)(t + 1) * kstep;
            const char* a2 = last ? nA : cA + (size_t)(t + 2) * kstep; const char* b2 = last ? nB : cB + (size_t)(t + 2) * kstep;
            const char* a3 = a2 + kstep; const char* b3 = b2 + kstep;
            PG8_LDB(B0, 0, 0); PG8_LDB(B1, 0, 1); PG8_SCHED; PG8_LDA(At, 0, 0); PG8_STAGE(PG8_SA(1, 1), a1 + hstepA, voffA);
            PG8_WAIT_V(8); PG8_WAIT_L(0); PG8_BAR; PG8_MMA(0, 0, At, B0); PG8_MMA(0, 1, At, B1); PG8_BAR; PG8_SCHED;
            PG8_LDA(At, 0, 1); PG8_STAGE(PG8_SB(0, 0), b2, voffB); PG8_STAGE(PG8_SB(0, 1), b2 + hstepB, voffB); PG8_STAGE(PG8_SA(0, 0), a2, voffA);
            PG8_WAIT_V(8); PG8_WAIT_L(0); PG8_BAR; PG8_MMA(1, 0, At, B0); PG8_MMA(1, 1, At, B1); PG8_BAR; PG8_SCHED;
            PG8_LDB(B0, 1, 0); PG8_LDB(B1, 1, 1); PG8_SCHED; PG8_LDA(At, 1, 0); PG8_STAGE(PG8_SA(0, 1), a2 + hstepA, voffA);
            PG8_WAIT_V(8); PG8_WAIT_L(0); PG8_BAR; PG8_MMA(0, 0, At, B0); PG8_MMA(0, 1, At, B1); PG8_BAR; PG8_SCHED;
            PG8_LDA(At, 1, 1); PG8_STAGE(PG8_SB(1, 0), b3, voffB); PG8_STAGE(PG8_SB(1, 1), b3 + hstepB, voffB); PG8_STAGE(PG8_SA(1, 0), a3, voffA);
            PG8_WAIT_V(8); PG8_WAIT_L(0); PG8_BAR; PG8_MMA(1, 0, At, B0); PG8_MMA(1, 1, At, B1); PG8_BAR; PG8_SCHED;
        }
        if (wr == 0) PG8_BAR;
        E(acc, cur, wr, wc, fr, fq);
        if (!has_next) break;
#pragma unroll
        for (int a = 0; a < 2; ++a)
#pragma unroll
            for (int b = 0; b < 2; ++b)
#pragma unroll
                for (int m = 0; m < 4; ++m)
#pragma unroll
                    for (int n = 0; n < 2; ++n) acc[a][b][m][n] = (f32x4){0.f, 0.f, 0.f, 0.f};
        cur = nxt; cA = nA; cB = nB; ++ui;
        if (wr == 1) PG8_BAR;
    }
    PG8_WAIT_V(0);
    PG8_BAR;
#undef PG8_SA
#undef PG8_SB
#undef PG8_STAGE
#undef PG8_LDA
#undef PG8_LDB
#undef PG8_MMA
#undef PG8_WAIT_V
#undef PG8_WAIT_L
#undef PG8_BAR
#undef PG8_SCHED
#undef PG8_BASEA
#undef PG8_BASEB
}
}

struct Ctx { LAS unsigned char* lds; int tid, lane, wave, bid, G; };
__device__ __forceinline__ Ctx relaunder(const Ctx& F0) { Ctx F = F0; int t = threadIdx.x; asm volatile("" : "+v"(t)); F.tid = t; F.lane = t & 63; F.wave = __builtin_amdgcn_readfirstlane(t >> 6); return F; }

template <bool AVPERM>
__device__ __forceinline__ void transpose_item(const float* W, int K, int N, bf16_t* WT, int row_off, LAS float* scr, int item, int lane) {
    const int nblk = N / 32, kb = item / nblk, nb = item % nblk, k0 = 64 * kb, n0 = 32 * nb;
    const int d0 = AVPERM ? (n0 < FF ? (n0 >> 7) * 256 + (n0 & 127) : ((n0 - FF) >> 7) * 256 + 128 + ((n0 - FF) & 127)) : n0;
    float wv[32];
#pragma unroll
    for (int i = 0; i < 32; ++i) { const int kk = 2 * i + (lane >> 5); wv[i] = W[(size_t)(k0 + kk) * N + n0 + (lane & 31)]; }
#pragma unroll
    for (int i = 0; i < 32; ++i) { const int kk = 2 * i + (lane >> 5); scr[kk * 33 + (lane & 31)] = wv[i]; }
    LDS_WAIT(); asm volatile("" ::: "memory");
    const int c = lane & 7;
#pragma unroll
    for (int j = 0; j < 4; ++j) { const int n = (lane >> 3) + 8 * j; const LAS float* s = scr + (8 * c) * 33 + n;
        u32x4 o; o.x = pk2(s[0 * 33], s[1 * 33]); o.y = pk2(s[2 * 33], s[3 * 33]); o.z = pk2(s[4 * 33], s[5 * 33]); o.w = pk2(s[6 * 33], s[7 * 33]);
        *(u32x4*)(WT + (size_t)(row_off + d0 + n) * K + k0 + 8 * c) = o; }
    LDS_WAIT(); asm volatile("" ::: "memory");
}
template <bool AVPERM = false>
__device__ __forceinline__ void transpose_matrix(const Ctx& F0, const float* W, int K, int N, bf16_t* WT, int row_off) {
    const Ctx F = relaunder(F0);
    LAS float* scr = (LAS float*)(F.lds + F.wave * 16384);
    const int gw = F.bid * NWAVES + F.wave, NGW = F.G * NWAVES, items = (K / 64) * (N / 32);
    for (int it = gw; it < items; it += NGW) transpose_item<AVPERM>(W, K, N, WT, row_off, scr, it, F.lane);
}

__device__ __forceinline__ void unpack8(const u32x4 w, float (&f)[8]) { f[0] = bflo(w.x); f[1] = bfhi(w.x); f[2] = bflo(w.y); f[3] = bfhi(w.y); f[4] = bflo(w.z); f[5] = bfhi(w.z); f[6] = bflo(w.w); f[7] = bfhi(w.w); }
__device__ __forceinline__ u32x4 pack8(const float (&f)[8]) { u32x4 w; w.x = pk2(f[0], f[1]); w.y = pk2(f[2], f[3]); w.z = pk2(f[4], f[5]); w.w = pk2(f[6], f[7]); return w; }

__device__ __forceinline__ void fold_pool_weights(const Ctx& F0, const float* wgrp, const float* pscale, const float* wout, bf16_t* WT) {
    const Ctx F = relaunder(F0);
    LAS float* WgS = (LAS float*)F.lds;
    LAS float* WoS = WgS + 4096;
    __syncthreads();
    for (int t = F.bid; t < 512; t += F.G) {
        const int L = t >> 8, kt = (t >> 4) & 15, nt = t & 15, k0 = kt * 64, n0 = nt * 64, g = k0 >> 8;
        const float* Wg = wgrp + (size_t)(L * 4 + g) * 65536 + (size_t)(k0 & 255) * 256;
        const float* Wo = wout + (size_t)L * DM * DM + (size_t)(g * 256) * DM + n0;
        const float* sc = pscale + L * DM + g * 256;
        const int n = F.tid & 63, kg = F.tid >> 6;
        float acc[8];
#pragma unroll
        for (int e = 0; e < 8; ++e) acc[e] = 0.f;
        for (int j0 = 0; j0 < 256; j0 += 64) {
#pragma unroll
            for (int i = 0; i < 8; ++i) { const int idx = F.tid + NTHREADS * i, r = idx >> 6, c = idx & 63;
                WgS[r * 64 + c] = Wg[(size_t)r * 256 + j0 + c];
                WoS[r * 64 + c] = Wo[(size_t)(j0 + r) * DM + c] * sc[j0 + r]; }
            __syncthreads();
#pragma unroll 8
            for (int j = 0; j < 64; ++j) { const float b = WoS[j * 64 + n];
#pragma unroll
                for (int e = 0; e < 8; ++e) acc[e] += WgS[(8 * kg + e) * 64 + j] * b; }
            __syncthreads();
        }
        *(u32x4*)(WT + (size_t)L * DM * DM + (size_t)(n0 + n) * DM + k0 + 8 * kg) = pack8(acc);
    }
}

__device__ __forceinline__ void mod_phase(const Ctx& F0, const float* c, const float* ada_w, const float* ada_b, const float* kv_ada_w, const float* kv_ada_b, float* mod, float* kvmod) {
    const Ctx F = relaunder(F0);
    LAS float* condT = (LAS float*)(F.lds + 131072 - 49152);
    LAS float* part = condT + 8192;
    __syncthreads();
    for (int i = F.tid; i < 8192; i += NTHREADS) { const int b = i >> 10, k = i & 1023; const float v = c[i]; condT[k * 8 + b] = v / (1.f + __expf(-v)); }
    __syncthreads();
    for (int it = F.bid; it < 416; it += F.G) {
        const float* W; const float* bias; float* outp; int N, cb;
        if (it < 384) { const int L = it / 96; cb = it % 96; W = ada_w + (size_t)L * 1024 * 6144; N = 6144; bias = ada_b + L * 6144; outp = mod + (size_t)L * 8 * 6144; }
        else { cb = it - 384; W = kv_ada_w; N = 2048; bias = kv_ada_b; outp = kvmod; }
        const int cl = F.tid & 63, kq = F.tid >> 6, col = cb * 64 + cl;
        float a0 = 0.f, a1 = 0.f, a2 = 0.f, a3 = 0.f, a4 = 0.f, a5 = 0.f, a6 = 0.f, a7 = 0.f;
#pragma unroll 16
        for (int k = kq * 128; k < kq * 128 + 128; ++k) {
            const float w = W[(size_t)k * N + col]; const f32x4 c0 = *(const LAS f32x4*)(condT + k * 8), c1 = *(const LAS f32x4*)(condT + k * 8 + 4);
            a0 += w * c0[0]; a1 += w * c0[1]; a2 += w * c0[2]; a3 += w * c0[3]; a4 += w * c1[0]; a5 += w * c1[1]; a6 += w * c1[2]; a7 += w * c1[3];
        }
        part[(kq * 8 + 0) * 64 + cl] = a0; part[(kq * 8 + 1) * 64 + cl] = a1; part[(kq * 8 + 2) * 64 + cl] = a2; part[(kq * 8 + 3) * 64 + cl] = a3;
        part[(kq * 8 + 4) * 64 + cl] = a4; part[(kq * 8 + 5) * 64 + cl] = a5; part[(kq * 8 + 6) * 64 + cl] = a6; part[(kq * 8 + 7) * 64 + cl] = a7;
        __syncthreads();
        { const int b = F.tid >> 6; float s = bias[cb * 64 + cl];
#pragma unroll
          for (int q = 0; q < 8; ++q) s += part[(q * 8 + b) * 64 + cl];
          outp[(size_t)b * N + cb * 64 + cl] = s; }
        __syncthreads();
    }
}

template <bool XBF16>
__device__ __forceinline__ void norm_phase(const Ctx& F0, const void* Xv, bf16_t* H, const float* g, const float* shift, const float* scale, int bstride, int row0, int nrows) {
    const Ctx F = relaunder(F0);
    const int gw = F.bid * NWAVES + F.wave, NGW = F.G * NWAVES;
    const int rpw = (nrows + NGW - 1) / NGW;
    int r = row0 + gw * rpw; const int rend = min(row0 + nrows, r + rpw);
    int curb = -1; f32x4 gs[4], shv[4];
    for (; r < rend; ++r) {
        const int b = r >> 12;
        if (b != curb) { curb = b;
#pragma unroll
            for (int j = 0; j < 4; ++j) { const int col = 4 * F.lane + 256 * j; const f32x4 gg = *(const f32x4*)(g + col), sc = *(const f32x4*)(scale + (size_t)b * bstride + col);
                gs[j] = gg * (sc + 1.f); shv[j] = *(const f32x4*)(shift + (size_t)b * bstride + col); } }
        f32x4 v[4]; float ss = 0.f;
        if (XBF16) { const u32x2* xr = (const u32x2*)((const bf16_t*)Xv + (size_t)r * DM) + F.lane;
#pragma unroll
            for (int j = 0; j < 4; ++j) { const u32x2 w = xr[64 * j]; v[j] = (f32x4){bflo(w.x), bfhi(w.x), bflo(w.y), bfhi(w.y)}; } }
        else { const f32x4* xr = (const f32x4*)((const float*)Xv + (size_t)r * DM) + F.lane;
#pragma unroll
            for (int j = 0; j < 4; ++j) v[j] = xr[64 * j]; }
#pragma unroll
        for (int j = 0; j < 4; ++j) ss += (v[j].x * v[j].x + v[j].y * v[j].y) + (v[j].z * v[j].z + v[j].w * v[j].w);
        const float rstd = 1.f / sqrtf(wave_sum(ss) * (1.f / DM) + EPS);
        u32x2* o8 = (u32x2*)(H + (size_t)(r - row0) * DM) + F.lane;
#pragma unroll
        for (int j = 0; j < 4; ++j) { const f32x4 y = v[j] * rstd * gs[j] + shv[j]; u32x2 w; w.x = pk2(y.x, y.y); w.y = pk2(y.z, y.w); o8[64 * j] = w; }
    }
}
__device__ __forceinline__ void final_norm_phase(const Ctx& F0, const bf16_t* Xs, int soff, float* out, const float* g, int r0, int r1) {
    const Ctx F = relaunder(F0);
    const int gw = F.bid * NWAVES + F.wave, NGW = F.G * NWAVES;
    f32x4 gs[4];
#pragma unroll
    for (int j = 0; j < 4; ++j) gs[j] = *(const f32x4*)(g + 4 * F.lane + 256 * j);
    for (int r = r0 + gw; r < r1; r += NGW) {
        const u32x2* xr = (const u32x2*)(Xs + (size_t)(r - soff) * DM) + F.lane;
        f32x4 v[4]; float ss = 0.f;
#pragma unroll
        for (int j = 0; j < 4; ++j) { const u32x2 w = xr[64 * j]; v[j] = (f32x4){bflo(w.x), bfhi(w.x), bflo(w.y), bfhi(w.y)}; ss += (v[j].x * v[j].x + v[j].y * v[j].y) + (v[j].z * v[j].z + v[j].w * v[j].w); }
        const float rstd = 1.f / sqrtf(wave_sum(ss) * (1.f / DM) + EPS);
        f32x4* orow = (f32x4*)(out + (size_t)r * DM) + F.lane;
#pragma unroll
        for (int j = 0; j < 4; ++j) orow[64 * j] = v[j] * rstd * gs[j];
    }
}
__device__ __forceinline__ void copy_rows_phase(const Ctx& F0, const bf16_t* src, bf16_t* dst, int nrows) {
    const Ctx F = relaunder(F0);
    const int gw = F.bid * NWAVES + F.wave, NGW = F.G * NWAVES;
    for (int r = gw; r < nrows; r += NGW) { const u32x4* s = (const u32x4*)(src + (size_t)r * DM) + F.lane; u32x4* d = (u32x4*)(dst + (size_t)r * DM) + F.lane; d[0] = s[0]; d[64] = s[64]; }
}
__device__ __forceinline__ void pool_phase(const Ctx& F0, const bf16_t* U, bf16_t* PB) {
    const Ctx F = relaunder(F0);
    const int nitems = (MTOT / 32) * 128;
    for (int it = F.bid * NTHREADS + F.tid; it < nitems; it += F.G * NTHREADS) {
        const int rb = it >> 7, ch = it & 127, t0 = rb * 32, col = ch * 8, w = 2 << (col >> 8), st0 = t0 & 4095;
        float sum[8];
#pragma unroll
        for (int e = 0; e < 8; ++e) sum[e] = 0.f;
        for (int j = 1; j <= w; ++j) if (st0 - j >= 0) { float f[8]; unpack8(*(const u32x4*)(U + (size_t)(t0 - j) * DM + col), f);
#pragma unroll
            for (int e = 0; e < 8; ++e) sum[e] += f[e]; }
        for (int i = 0; i < 32; ++i) {
            const int t = t0 + i, st = st0 + i; float ut[8]; unpack8(*(const u32x4*)(U + (size_t)t * DM + col), ut);
#pragma unroll
            for (int e = 0; e < 8; ++e) sum[e] += ut[e];
            if (st >= w) { float f[8]; unpack8(*(const u32x4*)(U + (size_t)(t - w) * DM + col), f);
#pragma unroll
                for (int e = 0; e < 8; ++e) sum[e] -= f[e]; }
            const float inv = 1.f / (float)min(st + 1, w); float o[8];
#pragma unroll
            for (int e = 0; e < 8; ++e) o[e] = sum[e] * inv - ut[e];
            *(u32x4*)(PB + (size_t)t * DM + col) = pack8(o);
        }
    }
}

template <class Sched>
__device__ __forceinline__ void conv_fix_units(const Ctx& F0, const Sched& S, bf16_t* G, const float* cw, const float* cb, const float* halo, const float* raw0, int row0) {
    const Ctx F = relaunder(F0);
    pg8::Unit u;
    for (int i = 0; S.next(i, u); ++i) {
        const int tile = u.pm;
        if (F.tid < 352) {
            const int col = F.tid * 8;
            const bool seq0 = (((row0 + tile * 256) & 4095) == 0);
            float h254[8], h255[8];
#pragma unroll
            for (int e = 0; e < 8; ++e) { h254[e] = 0.f; h255[e] = 0.f; }
            if (!seq0) { const float* hp = halo + ((size_t)(tile - 1) * 2) * FF + col;
#pragma unroll
                for (int e = 0; e < 8; ++e) { h254[e] = hp[e]; h255[e] = hp[FF + e]; } }
            const float* rp = raw0 + ((size_t)tile * 2) * NUP + col;
            float o0[8], o1[8];
#pragma unroll
            for (int e = 0; e < 8; ++e) { const float a0 = rp[e], v0 = rp[FF + e], a1 = rp[NUP + e], v1 = rp[NUP + FF + e];
                const float w0 = cw[col + e], w1 = cw[FF + col + e], w2 = cw[2 * FF + col + e], bb = cb[col + e];
                const float y0 = bb + w0 * h254[e] + w1 * h255[e] + w2 * a0, y1 = bb + w0 * h255[e] + w1 * a0 + w2 * a1;
                o0[e] = y0 / (1.f + __expf(-y0)) * v0; o1[e] = y1 / (1.f + __expf(-y1)) * v1; }
            *(u32x4*)(G + (size_t)(tile * 256) * FF + col) = pack8(o0); *(u32x4*)(G + (size_t)(tile * 256 + 1) * FF + col) = pack8(o1);
        }
    }
    asm volatile("s_waitcnt vmcnt(0)" ::: "memory");
    __syncthreads();
}

__device__ __forceinline__ int crow(int r, int hi) { return (r & 3) + 8 * (r >> 2) + 4 * hi; }
template <bool MERGE>
__device__ __forceinline__ void attn_phase(const Ctx& F0, bf16_t* Qc, const bf16_t* KVc, float* LSE, bf16_t* OM, int u_lo, int u_hi) {
    const Ctx F = relaunder(F0);
    LAS unsigned char* lds = F.lds;
    const int tid = F.tid, lane = F.lane, wid = F.wave, q = lane & 31, hi = lane >> 5;
    constexpr size_t MAT = (size_t)MC * 1024;
    constexpr int VOFF = 49152;
    const int q4 = (lane & 15) >> 2, p4 = lane & 3, dc16 = (lane >> 4) & 1;
    const int slot_l = tid >> 3, c_l = tid & 7;
    u32x4 kreg[6], vreg[6]; bf16x8 qn[4];
#define ATT_DECODE(u, h, rb, g, sh, prow0, has_prev) const int h = (u) & 15, rb = ((u) >> 4) & 63, g = (u) >> 10, sh = 2 * g, prow0 = rb * 256; const bool has_prev = ((prow0 & ((4096 >> sh) - 1)) != 0)
#define ATT_ISSUE(u) do { ATT_DECODE(u, h_, rb_, g_, sh_, prow0_, hp_); \
        const bf16_t* Kg_ = KVc + (size_t)g_ * MAT + (size_t)h_ * MC * 64 + c_l * 8; const bf16_t* Vg_ = KVc + (size_t)(3 + g_) * MAT + (size_t)h_ * MC * 64 + c_l * 8; \
        _Pragma("unroll") for (int i = 0; i < 6; ++i) if (hp_ || i >= 2) { const long prow = (long)prow0_ - 128 + slot_l + 64 * i; kreg[i] = *(const u32x4*)(Kg_ + prow * 64); vreg[i] = *(const u32x4*)(Vg_ + prow * 64); } \
        const bf16_t* Qw_ = Qc + (size_t)g_ * MAT + ((size_t)h_ * MC + prow0_ + 32 * wid + q) * 64; \
        _Pragma("unroll") for (int s = 0; s < 4; ++s) qn[s] = *(const bf16x8*)(Qw_ + 16 * s + 8 * hi); } while (0)
    const int NUNITS = u_hi;
    int u = u_lo + F.bid;
    if (u < NUNITS) ATT_ISSUE(u);
    while (u < NUNITS) {
        ATT_DECODE(u, h, rb, g, sh, prow0, has_prev);
        bf16_t* Qw = Qc + (size_t)g * MAT + ((size_t)h * MC + prow0 + 32 * wid + q) * 64;
        bf16x8 qf[4];
#pragma unroll
        for (int s = 0; s < 4; ++s) qf[s] = qn[s];
#pragma unroll
        for (int i = 0; i < 6; ++i) if (has_prev || i >= 2) { const int slot = slot_l + 64 * i;
            *(LAS u32x4*)(lds + slot * 128 + ((c_l ^ ((slot >> 1) & 7)) << 4)) = kreg[i];
            *(LAS u32x4*)(lds + VOFF + slot * 128 + ((c_l << 4) ^ (((slot >> 1) & 1) << 6))) = vreg[i]; }
        __syncthreads();
        const int un = u + F.G;
        if (un < NUNITS) ATT_ISSUE(un);
        const int ii = g * 16 + h; const float ee = ii < 32 ? 0.125f * (float)(ii + 1) : 4.0f + 0.25f * (float)(ii - 31);
        const float slope2 = exp2f(-ee) * (float)(1 << sh) * LOG2E;
        float mx = -INFINITY, lsum = 0.f;
        f32x16 o0 = {0.f, 0.f, 0.f, 0.f, 0.f, 0.f, 0.f, 0.f, 0.f, 0.f, 0.f, 0.f, 0.f, 0.f, 0.f, 0.f}, o1 = o0;
        f32x16 cf;
#pragma unroll
        for (int r = 0; r < 16; ++r) cf[r] = slope2 * (float)crow(r, hi);
        const int qq = q - 4 * hi;
        const int i0 = has_prev ? 0 : (wid < 4 ? 4 - wid : 0);
#define ATT_TILE(i, MASKLO, MASKHI) do { \
            const int sb = 32 * wid + 32 * (i); \
            const float base = -slope2 * (float)(q + 128 - 32 * (i)); \
            f32x16 a; \
            _Pragma("unroll") for (int r = 0; r < 16; ++r) a[r] = cf[r] + base; \
            { const int slot = sb + q; \
              _Pragma("unroll") for (int s = 0; s < 4; ++s) { const int c = 2 * s + hi; const bf16x8 kf = *(const LAS bf16x8*)(lds + slot * 128 + ((c ^ ((slot >> 1) & 7)) << 4)); \
                  a = __builtin_amdgcn_mfma_f32_32x32x16_bf16(kf, qf[s], a, 0, 0, 0); } } \
            if (MASKHI) { _Pragma("unroll") for (int r = 0; r < 16; ++r) if (crow(r, 0) > qq) a[r] = -INFINITY; }     \
            if (MASKLO) { _Pragma("unroll") for (int r = 0; r < 16; ++r) if (crow(r, 0) < qq) a[r] = -INFINITY; }     \
            float tmax = fmaxf(fmaxf(a[0], a[1]), fmaxf(a[2], a[3])); \
            _Pragma("unroll") for (int r = 4; r < 16; r += 4) tmax = fmaxf(tmax, fmaxf(fmaxf(a[r], a[r + 1]), fmaxf(a[r + 2], a[r + 3]))); \
            tmax = fmaxf(tmax, __shfl_xor(tmax, 32)); \
            if (__any(tmax > mx)) { const float mnew = fmaxf(mx, tmax); const float alpha = __builtin_amdgcn_exp2f(mx - mnew); mx = mnew; lsum *= alpha; \
                _Pragma("unroll") for (int r = 0; r < 16; ++r) { o0[r] *= alpha; o1[r] *= alpha; } } \
            float ps = 0.f; \
            _Pragma("unroll") for (int r = 0; r < 16; ++r) { const float p = __builtin_amdgcn_exp2f(a[r] - mx); a[r] = p; ps += p; } \
            lsum += ps; \
            _Pragma("unroll") for (int s2 = 0; s2 < 2; ++s2) { \
                u32x4 pw; pw.x = cvt_pk_bf16(a[8 * s2 + 0], a[8 * s2 + 1]); pw.y = cvt_pk_bf16(a[8 * s2 + 2], a[8 * s2 + 3]); \
                pw.z = cvt_pk_bf16(a[8 * s2 + 4], a[8 * s2 + 5]); pw.w = cvt_pk_bf16(a[8 * s2 + 6], a[8 * s2 + 7]); \
                const bf16x8 pf = __builtin_bit_cast(bf16x8, pw); \
                const int slotA = sb + 16 * s2 + 4 * hi + q4; \
                _Pragma("unroll") for (int dh = 0; dh < 2; ++dh) { \
                    const int colb = (32 * dh + 16 * dc16 + 4 * p4) * 2; \
                    const int addr = VOFF + slotA * 128 + (colb ^ (((slotA >> 1) & 1) << 6)); \
                    const s16x4 lo = __builtin_bit_cast(s16x4, __builtin_amdgcn_ds_read_tr16_b64_v4i16((LAS s16x4*)(lds + addr))); \
                    const s16x4 hh = __builtin_bit_cast(s16x4, __builtin_amdgcn_ds_read_tr16_b64_v4i16((LAS s16x4*)(lds + addr + 1024))); \
                    const bf16x8 vf = (bf16x8){lo[0], lo[1], lo[2], lo[3], hh[0], hh[1], hh[2], hh[3]}; \
                    if (dh == 0) o0 = __builtin_amdgcn_mfma_f32_32x32x16_bf16(vf, pf, o0, 0, 0, 0); \
                    else o1 = __builtin_amdgcn_mfma_f32_32x32x16_bf16(vf, pf, o1, 0, 0, 0); } } \
        } while (0)
        ATT_TILE(4, false, true);
        for (int i = 3; i >= 1 && i >= i0; --i) ATT_TILE(i, false, false);
        if (i0 == 0) ATT_TILE(0, true, false);
#undef ATT_TILE
        lsum += __shfl_xor(lsum, 32);
        if (!MERGE) {
            const float inv = 1.f / lsum;
#pragma unroll
            for (int rq = 0; rq < 4; ++rq) {
                u32x2 w0; w0.x = cvt_pk_bf16(o0[4 * rq + 0] * inv, o0[4 * rq + 1] * inv); w0.y = cvt_pk_bf16(o0[4 * rq + 2] * inv, o0[4 * rq + 3] * inv);
                u32x2 w1; w1.x = cvt_pk_bf16(o1[4 * rq + 0] * inv, o1[4 * rq + 1] * inv); w1.y = cvt_pk_bf16(o1[4 * rq + 2] * inv, o1[4 * rq + 3] * inv);
                *(u32x2*)(Qw + 8 * rq + 4 * hi) = w0; *(u32x2*)(Qw + 32 + 8 * rq + 4 * hi) = w1;
            }
            if (hi == 0) LSE[((size_t)g * MC + prow0 + 32 * wid + q) * 16 + h] = mx + log2f(lsum);
        } else {
            const int jq = 32 * wid + q, tt = 16 * jq + (rb & 15), bb0 = (rb >> 4) << 12;
            const int pr0 = bb0 + tt, pr1 = bb0 + ((tt & 3) << 10) + (tt >> 2);
            const float l0 = LSE[((size_t)pr0) * 16 + h], l1 = LSE[((size_t)MC + pr1) * 16 + h], l2 = mx + log2f(lsum);
            const float mm = fmaxf(l0, fmaxf(l1, l2));
            const float e0 = __builtin_amdgcn_exp2f(l0 - mm), e1 = __builtin_amdgcn_exp2f(l1 - mm), e2 = __builtin_amdgcn_exp2f(l2 - mm);
            const float invs = 1.f / (e0 + e1 + e2), wa = e0 * invs, wb = e1 * invs, wc2 = e2 * invs / lsum;
            const bf16_t* O0 = Qc + ((size_t)h * MC + pr0) * 64 + 4 * hi; const bf16_t* O1 = Qc + MAT + ((size_t)h * MC + pr1) * 64 + 4 * hi;
            bf16_t* om = OM + (size_t)pr0 * DM + h * 64 + 4 * hi;
#pragma unroll
            for (int rq = 0; rq < 4; ++rq) {
#pragma unroll
                for (int dh = 0; dh < 2; ++dh) {
                    const u32x2 a = *(const u32x2*)(O0 + 32 * dh + 8 * rq), b = *(const u32x2*)(O1 + 32 * dh + 8 * rq);
                    const float s0 = dh == 0 ? o0[4 * rq + 0] : o1[4 * rq + 0], s1 = dh == 0 ? o0[4 * rq + 1] : o1[4 * rq + 1], s2 = dh == 0 ? o0[4 * rq + 2] : o1[4 * rq + 2], s3 = dh == 0 ? o0[4 * rq + 3] : o1[4 * rq + 3];
                    u32x2 w; w.x = cvt_pk_bf16(wa * bflo(a.x) + wb * bflo(b.x) + wc2 * s0, wa * bfhi(a.x) + wb * bfhi(b.x) + wc2 * s1);
                    w.y = cvt_pk_bf16(wa * bflo(a.y) + wb * bflo(b.y) + wc2 * s2, wa * bfhi(a.y) + wb * bfhi(b.y) + wc2 * s3);
                    *(u32x2*)(om + 32 * dh + 8 * rq) = w;
                }
            }
        }
        __syncthreads();
        u = un;
    }
#undef ATT_DECODE
#undef ATT_ISSUE
}
__device__ __forceinline__ void merge_phase(const Ctx& F0, const bf16_t* Oc, const float* LSE, bf16_t* OM) {
    const Ctx F = relaunder(F0);
    const int gw = F.bid * NWAVES + F.wave, NGW = F.G * NWAVES;
    constexpr size_t MAT = (size_t)MC * 1024;
    const int col = F.lane * 16, h = F.lane >> 2;
    for (int r = gw; r < MC; r += NGW) {
        const int tt = r & 4095, bb = r & ~4095;
        int pr[3]; float l[3];
#pragma unroll
        for (int g = 0; g < 3; ++g) { const int sh = 2 * g; pr[g] = bb + ((tt & ((1 << sh) - 1)) << (12 - sh)) + (tt >> sh); l[g] = LSE[((size_t)g * MC + pr[g]) * 16 + h]; }
        const float mx = fmaxf(l[0], fmaxf(l[1], l[2]));
        float w[3]; w[0] = exp2f(l[0] - mx); w[1] = exp2f(l[1] - mx); w[2] = exp2f(l[2] - mx);
        const float inv = 1.f / (w[0] + w[1] + w[2]);
        float acc[16];
#pragma unroll
        for (int e = 0; e < 16; ++e) acc[e] = 0.f;
#pragma unroll
        for (int g = 0; g < 3; ++g) { const bf16_t* p = Oc + (size_t)g * MAT + ((size_t)h * MC + pr[g]) * 64 + (F.lane & 3) * 16; float f0[8], f1[8]; unpack8(*(const u32x4*)p, f0); unpack8(*(const u32x4*)(p + 8), f1);
            const float wg = w[g] * inv;
#pragma unroll
            for (int e = 0; e < 8; ++e) { acc[e] += wg * f0[e]; acc[8 + e] += wg * f1[e]; } }
        float o0[8], o1[8];
#pragma unroll
        for (int e = 0; e < 8; ++e) { o0[e] = acc[e]; o1[e] = acc[8 + e]; }
        bf16_t* op = OM + (size_t)r * DM + col; *(u32x4*)op = pack8(o0); *(u32x4*)(op + 8) = pack8(o1);
    }
}

#define XB_TMO      128
#define XB_XCNT(j)  (256  + 64 * (j))
#define XB_XSUB(j)  (1280 + 64 * (j))
#define XB_XGEN(j)  (2304 + 64 * (j))
#define XB_TOP      3328
#define XB_TOPGEN   3392
#define XCD_BAR_WORDS 3456
#define XB_SPIN_CAP (1u << 18)
__device__ __forceinline__ unsigned xb_ld(unsigned* p)              { return __hip_atomic_load(p, __ATOMIC_RELAXED, __HIP_MEMORY_SCOPE_AGENT); }
__device__ __forceinline__ unsigned xb_add(unsigned* p, unsigned v) { return __hip_atomic_fetch_add(p, v, __ATOMIC_RELAXED, __HIP_MEMORY_SCOPE_AGENT); }
__device__ __forceinline__ unsigned xb_xcc_id() { return (unsigned)__builtin_amdgcn_s_getreg((3 << 11) | 20) & 0xFu; }
#define XB_SPIN(cond, bar) do { unsigned _sp = 0; while (cond) { __builtin_amdgcn_s_sleep(1); \
    if ((++_sp & 255u) == 0u) { if (xb_ld(&(bar)[XB_TMO])) break; if (_sp > XB_SPIN_CAP) { atomicAdd(&(bar)[XB_TMO], 1u); break; } } } } while (0)
struct XcdBarrier { unsigned* bar; unsigned x; volatile LAS unsigned* st; };
__device__ __forceinline__ XcdBarrier xcd_barrier_post(unsigned* bar, volatile LAS unsigned* st) {
    XcdBarrier b; b.bar = bar; b.x = xb_xcc_id(); b.st = st;
    if (threadIdx.x == 0) (void)xb_add(&bar[XB_XCNT(b.x)], 1u);
    return b;
}
__device__ __forceinline__ void xcd_barrier_complete(unsigned* bar, unsigned x, unsigned& nloc, unsigned& nx) {
    const unsigned G = gridDim.x * gridDim.y * gridDim.z;
    unsigned sum, cnt, mine, sp = 0u;
    for (;;) {
        sum = 0u; cnt = 0u; mine = 0u;
#pragma unroll
        for (unsigned j = 0; j < 16; ++j) { const unsigned c = xb_ld(&bar[XB_XCNT(j)]); sum += c; cnt += (c > 0u) ? 1u : 0u; mine = (j == x) ? c : mine; }
        if (sum == G) break;
        __builtin_amdgcn_s_sleep(1);
        if ((++sp & 255u) == 0u) { if (xb_ld(&bar[XB_TMO])) break; if (sp > XB_SPIN_CAP) { atomicAdd(&bar[XB_TMO], 1u); break; } }
    }
    nloc = mine > 0u ? mine : 1u; nx = cnt > 0u ? cnt : 1u;
}
__device__ __forceinline__ void xcd_barrier(const XcdBarrier& b) {
    asm volatile("s_waitcnt vmcnt(0)" ::: "memory");
    __syncthreads();
    int t0_ = threadIdx.x; asm volatile("" : "+v"(t0_));
    if (t0_ == 0) {
        unsigned* bar = b.bar; unsigned bx = b.x; asm volatile("" : "+s"(bx));
        __builtin_amdgcn_s_waitcnt(0);
        unsigned nloc = b.st[0], nx = b.st[1];
        if (nloc == 0u) { xcd_barrier_complete(bar, bx, nloc, nx); b.st[0] = nloc; b.st[1] = nx; }
        const unsigned old = xb_add(&bar[XB_XSUB(bx)], 1u);
        const unsigned gen = old / nloc;
        if (old + 1u == (gen + 1u) * nloc) {
            __builtin_amdgcn_fence(__ATOMIC_RELEASE, "agent");
            asm volatile("s_waitcnt vmcnt(0)" ::: "memory");
            const unsigned og = xb_add(&bar[XB_TOP], 1u);
            const unsigned tg = og / nx;
            if (og + 1u == (tg + 1u) * nx) xb_add(&bar[XB_TOPGEN], 1u);
            else XB_SPIN(xb_ld(&bar[XB_TOPGEN]) == tg, bar);
            __builtin_amdgcn_fence(__ATOMIC_ACQUIRE, "agent");
            xb_add(&bar[XB_XGEN(bx)], 1u);
            asm volatile("s_waitcnt vmcnt(0)" ::: "memory");
        } else {
            XB_SPIN(xb_ld(&bar[XB_XGEN(bx)]) == gen, bar);
            __builtin_amdgcn_fence(__ATOMIC_ACQUIRE, "agent");
            asm volatile("s_waitcnt vmcnt(0)" ::: "memory");
        }
    }
    __syncthreads();
}

struct Args { const float* in[21]; float* out; unsigned char* ws; };
enum { I_X = 0, I_C, I_ADAW, I_ADAB, I_N1G, I_N2G, I_PWIN, I_PWGRP, I_PSCALE, I_PWOUT, I_KVNG, I_KVADAW, I_KVADAB, I_WKV, I_WQ, I_WO, I_WUP, I_CONVW, I_CONVB, I_WDN, I_FING };

__global__ void __launch_bounds__(NTHREADS, 2) mega_fwd(Args a) {
    extern __shared__ __attribute__((aligned(16))) unsigned char lds_raw[];
    cg::grid_group grid = cg::this_grid();
    Ctx F; F.lds = (LAS unsigned char*)lds_raw; F.tid = threadIdx.x; F.lane = F.tid & 63; F.wave = __builtin_amdgcn_readfirstlane(F.tid >> 6); F.bid = blockIdx.x; F.G = gridDim.x;
    unsigned char* ws = a.ws;
    float* mod = (float*)(ws + WS_MOD); float* kvmod = (float*)(ws + WS_KVMOD);
    bf16_t* X = (bf16_t*)((unsigned char*)a.out + 64 * MiB);
    float* halo = (float*)(ws + WS_HALO); float* raw0 = (float*)(ws + WS_RAW0);
    LAS float* xch = (LAS float*)(F.lds + 131072 + 4096);
#define GSYNC_CG() do { asm volatile("s_waitcnt vmcnt(0)" ::: "memory"); grid.sync(); __builtin_amdgcn_fence(__ATOMIC_ACQUIRE, "agent"); } while (0)
#define GSYNC() xcd_barrier(bar)
    volatile LAS unsigned* MISC = (volatile LAS unsigned*)(F.lds + 131072 + 320);
    if (F.tid < 32) MISC[F.tid] = 0u;
    unsigned* barw = (unsigned*)(ws + WS_BAR);
    __syncthreads();

    for (int L = 0; L < 2; ++L) {
        transpose_matrix(F, a.in[I_PWIN] + (size_t)L * DM * DM, DM, DM, (bf16_t*)(ws + WA_WIN) + (size_t)L * DM * DM, 0);
        transpose_matrix<true>(F, a.in[I_WUP] + (size_t)L * DM * NUP, DM, NUP, (bf16_t*)(ws + WA_WUP) + (size_t)L * DM * NUP, 0);
        transpose_matrix(F, a.in[I_WDN] + (size_t)L * FF * DM, FF, DM, (bf16_t*)(ws + WA_WDN) + (size_t)L * FF * DM, 0);
    }
    fold_pool_weights(F, a.in[I_PWGRP], a.in[I_PSCALE], a.in[I_PWOUT], (bf16_t*)(ws + WA_WOUT));
    mod_phase(F, a.in[I_C], a.in[I_ADAW], a.in[I_ADAB], a.in[I_KVADAW], a.in[I_KVADAB], mod, kvmod);
    const XcdBarrier bar = xcd_barrier_post(barw, MISC + 8);
    if (a.ws == nullptr) GSYNC_CG();
    GSYNC();

    for (int L = 0; L < 2; ++L) {
        const float* modL = mod + (size_t)L * 8 * 6144;
        bf16_t* H = (bf16_t*)(ws + WA_H); bf16_t* U = (bf16_t*)(ws + WA_U); bf16_t* PB = (bf16_t*)(ws + WA_PB); bf16_t* AV = (bf16_t*)(ws + WA_AV);
        if (L == 0) norm_phase<false>(F, a.in[I_X], H, a.in[I_N1G] + L * DM, modL + 0, modL + 1024, 6144, 0, MTOT);
        else norm_phase<true>(F, X, H, a.in[I_N1G] + L * DM, modL + 0, modL + 1024, 6144, 0, MTOT);
        GSYNC();
        { pg8::Gemm g{H, (bf16_t*)(ws + WA_WIN) + (size_t)L * DM * DM, MTOT, DM, DM, DM, DM, 0}; pg8::StaticOrder S; S.init(MTOT, DM, F.G, F.bid);
          pg8::EpiBf16 E{U, DM, nullptr}; pg8::gemm_phase(F.lds, g, S, E); }
        GSYNC();
        pool_phase(F, U, PB);
        GSYNC();
        { pg8::Gemm g{PB, (bf16_t*)(ws + WA_WOUT) + (size_t)L * DM * DM, MTOT, DM, DM, DM, DM, 0}; pg8::StaticOrder S; S.init(MTOT, DM, F.G, F.bid);
          if (L == 0) { pg8::EpiResid<true> E{a.in[I_X], nullptr, X, modL + 2048, 0}; pg8::gemm_phase(F.lds, g, S, E); }
          else { pg8::EpiResid<false> E{nullptr, X, X, modL + 2048, 0}; pg8::gemm_phase(F.lds, g, S, E); } }
        GSYNC();
        norm_phase<true>(F, X, H, a.in[I_N2G] + L * DM, modL + 3072, modL + 4096, 6144, 0, MTOT);
        GSYNC();
        { pg8::Gemm g{H, (bf16_t*)(ws + WA_WUP) + (size_t)L * DM * NUP, MTOT, NUP, DM, DM, DM, 0}; pg8::StaticOrder S; S.init(MTOT, NUP, F.G, F.bid);
          pg8::EpiConvGate E{AV, a.in[I_CONVW] + (size_t)L * 3 * FF, a.in[I_CONVB] + (size_t)L * FF, halo, raw0, xch}; pg8::gemm_phase(F.lds, g, S, E); }
        GSYNC();
        { pg8::Gemm g{AV, (bf16_t*)(ws + WA_WDN) + (size_t)L * FF * DM, MTOT, DM, FF, FF, FF, 0}; pg8::StaticOrder S; S.init(MTOT, DM, F.G, F.bid);
          conv_fix_units(F, S, AV, a.in[I_CONVW] + (size_t)L * 3 * FF, a.in[I_CONVB] + (size_t)L * FF, halo, raw0, 0);
          pg8::EpiResid<false> E{nullptr, X, X, modL + 5120, 0}; pg8::gemm_phase(F.lds, g, S, E); }
        GSYNC();
    }

    transpose_matrix(F, a.in[I_WKV], DM, 6144, (bf16_t*)(ws + WB_WKV), 0);
    for (int j = 0; j < 2; ++j) {
        transpose_matrix(F, a.in[I_WQ] + (size_t)j * DM * 3072, DM, 3072, (bf16_t*)(ws + WB_WQ) + (size_t)j * DM * 3072, 0);
        transpose_matrix(F, a.in[I_WO] + (size_t)j * DM * DM, DM, DM, (bf16_t*)(ws + WB_WO) + (size_t)j * DM * DM, 0);
        transpose_matrix<true>(F, a.in[I_WUP] + (size_t)(2 + j) * DM * NUP, DM, NUP, (bf16_t*)(ws + WB_WUP) + (size_t)j * DM * NUP, 0);
        transpose_matrix(F, a.in[I_WDN] + (size_t)(2 + j) * FF * DM, FF, DM, (bf16_t*)(ws + WB_WDN) + (size_t)j * FF * DM, 0);
    }
    __syncthreads();

    for (int c = 0; c < 2; ++c) {
        const int row0 = c * MC;
        bf16_t* H = (bf16_t*)(ws + WB_H); bf16_t* KVc = (bf16_t*)(ws + WB_KV); bf16_t* Qc = (bf16_t*)(ws + WB_Q); bf16_t* AV = (bf16_t*)(ws + WB_AV); float* LSE = (float*)(ws + WB_LSE);
        bf16_t* H2 = (bf16_t*)(ws + WB_H2);
        { const float* mod2 = mod + (size_t)2 * 8 * 6144;
          norm_phase<true>(F, X, H, a.in[I_KVNG], kvmod + 0, kvmod + 1024, 2048, row0, MC);
          norm_phase<true>(F, X, H2, a.in[I_N1G] + 2 * DM, mod2 + 0, mod2 + 1024, 6144, row0, MC); }
        GSYNC();
        { pg8::Gemm g{H, (bf16_t*)(ws + WB_WKV), MC, 6144, DM, DM, DM, 0}; pg8::StaticOrder S; S.init(MC, 6144, F.G, F.bid);
          pg8::EpiQKV E{KVc, (size_t)MC * 1024, 1.0f}; pg8::gemm_phase(F.lds, g, S, E); }
        { pg8::Gemm g{H2, (bf16_t*)(ws + WB_WQ), MC, 3072, DM, DM, DM, 0}; pg8::StaticOrder S; S.init(MC, 3072, F.G, F.bid);
          pg8::EpiQKV E{Qc, (size_t)MC * 1024, 0.125f * LOG2E}; pg8::gemm_phase(F.lds, g, S, E); }
        GSYNC();
        for (int j = 0; j < 2; ++j) {
            const int L = 2 + j; const float* modL = mod + (size_t)L * 8 * 6144;
            if (j == 1) {
                norm_phase<true>(F, X, H, a.in[I_N1G] + L * DM, modL + 0, modL + 1024, 6144, row0, MC);
                GSYNC();
                { pg8::Gemm g{H, (bf16_t*)(ws + WB_WQ) + (size_t)j * DM * 3072, MC, 3072, DM, DM, DM, 0}; pg8::StaticOrder S; S.init(MC, 3072, F.G, F.bid);
                  pg8::EpiQKV E{Qc, (size_t)MC * 1024, 0.125f * LOG2E}; pg8::gemm_phase(F.lds, g, S, E); }
                GSYNC();
            }
            attn_phase<false>(F, Qc, KVc, LSE, H, 0, 2048);
            GSYNC();
            attn_phase<true>(F, Qc, KVc, LSE, H, 2048, 3072);
            GSYNC();
            { pg8::Gemm g{H, (bf16_t*)(ws + WB_WO) + (size_t)j * DM * DM, MC, DM, DM, DM, DM, 0}; pg8::StaticOrder S; S.init(MC, DM, F.G, F.bid);
              pg8::EpiResid<false> E{nullptr, X, X, modL + 2048, row0}; pg8::gemm_phase(F.lds, g, S, E); }
            GSYNC();
            norm_phase<true>(F, X, H, a.in[I_N2G] + L * DM, modL + 3072, modL + 4096, 6144, row0, MC);
            GSYNC();
            { pg8::Gemm g{H, (bf16_t*)(ws + WB_WUP) + (size_t)j * DM * NUP, MC, NUP, DM, DM, DM, 0}; pg8::StaticOrder S; S.init(MC, NUP, F.G, F.bid);
              pg8::EpiConvGate E{AV, a.in[I_CONVW] + (size_t)L * 3 * FF, a.in[I_CONVB] + (size_t)L * FF, halo, raw0, xch}; pg8::gemm_phase(F.lds, g, S, E); }
            GSYNC();
            { pg8::Gemm g{AV, (bf16_t*)(ws + WB_WDN) + (size_t)j * FF * DM, MC, DM, FF, FF, FF, 0}; pg8::StaticOrder S; S.init(MC, DM, F.G, F.bid);
              conv_fix_units(F, S, AV, a.in[I_CONVW] + (size_t)L * 3 * FF, a.in[I_CONVB] + (size_t)L * FF, halo, raw0, row0);
              bf16_t* Xo = (c == 1 && j == 1) ? (bf16_t*)(ws + WS_XTAIL) - (size_t)MC * DM : X;
              pg8::EpiResid<false> E{nullptr, X, Xo, modL + 5120, row0}; pg8::gemm_phase(F.lds, g, S, E); }
            GSYNC();
        }
    }
    final_norm_phase(F, X, 0, a.out, a.in[I_FING], 0, MC);
    GSYNC();
    final_norm_phase(F, (const bf16_t*)(ws + WS_XTAIL), MC, a.out, a.in[I_FING], MC, MTOT);
}

extern "C" void kernel_launch(void* const* d_in, const int* in_sizes, int n_in, void* d_out, int out_size, void* d_ws, size_t ws_size, hipStream_t stream) {
    static int grid = 0;
    if (grid == 0) {
        int dev = 0, cus = 0, per_cu = 0;
        if (n_in != 21 || out_size != MTOT * DM || ws_size < 512 * MiB) { fprintf(stderr, "kernel_launch: unexpected problem (n_in %d, out %d, ws %zu)\n", n_in, out_size, ws_size); grid = -1; return; }
        if (hipGetDevice(&dev) != hipSuccess || hipDeviceGetAttribute(&cus, hipDeviceAttributeMultiprocessorCount, dev) != hipSuccess) { grid = -1; return; }
        if (hipFuncSetAttribute((const void*)mega_fwd, hipFuncAttributeMaxDynamicSharedMemorySize, LDS_BYTES) != hipSuccess) { fprintf(stderr, "kernel_launch: hipFuncSetAttribute failed\n"); grid = -1; return; }
        if (hipOccupancyMaxActiveBlocksPerMultiprocessor(&per_cu, (const void*)mega_fwd, NTHREADS, LDS_BYTES) != hipSuccess || per_cu < 1) { fprintf(stderr, "kernel_launch: occupancy query says %d\n", per_cu); per_cu = 1; }
        (void)hipGetLastError();
        grid = cus;
    }
    if (grid < 0) return;
    Args a{};
    for (int i = 0; i < 21; ++i) a.in[i] = (const float*)d_in[i];
    a.out = (float*)d_out; a.ws = (unsigned char*)d_ws;
    if (hipMemsetAsync((unsigned char*)d_ws + WS_BAR, 0, XCD_BAR_WORDS * 4, stream) != hipSuccess) { fprintf(stderr, "kernel_launch: memset of the barrier words failed\n"); return; }
    void* args[] = {&a};
    hipError_t e = hipLaunchCooperativeKernel((const void*)mega_fwd, dim3(grid), dim3(NTHREADS), args, LDS_BYTES, stream);
    if (e != hipSuccess) fprintf(stderr, "kernel_launch: cooperative launch failed: %s (grid %d)\n", hipGetErrorString(e), grid);
}
```

```cpp
#include <hip/hip_runtime.h>
#include <hip/hip_cooperative_groups.h>
#include <cstdio>
#include <cstdint>
#include <cmath>
namespace cg = cooperative_groups;

#define LAS __attribute__((address_space(3)))
typedef unsigned short bf16_t;
typedef short bf16x8 __attribute__((ext_vector_type(8)));
typedef short s16x4 __attribute__((ext_vector_type(4)));
typedef float f32x4 __attribute__((ext_vector_type(4)));
typedef float f32x16 __attribute__((ext_vector_type(16)));
typedef unsigned u32x4 __attribute__((ext_vector_type(4)));
typedef unsigned u32x2 __attribute__((ext_vector_type(2)));

constexpr int SEQ = 4096, DM = 1024, NB = 8, MTOT = NB * SEQ, FF = 2816, NUP = 2 * FF, DEPTH = 4;
constexpr int MC = 16384;
constexpr float EPS = 1e-6f;
constexpr float LOG2E = 1.4426950408889634f;
constexpr int NTHREADS = 512, NWAVES = 8;
constexpr int LDS_BYTES = 147456;

constexpr size_t MiB = 1u << 20;
constexpr size_t WS_MOD = 0;
constexpr size_t WS_KVMOD = 4 * 8 * 6144 * 4;
constexpr size_t WS_BAR = 896 * 1024;
constexpr size_t WA_WIN = 1 * MiB;
constexpr size_t WA_WGRP = 5 * MiB;
constexpr size_t WA_WOUT = 6 * MiB;
constexpr size_t WA_WUP = 10 * MiB;
constexpr size_t WA_WDN = 32 * MiB;
constexpr size_t WA_H = 44 * MiB;
constexpr size_t WA_AV = 108 * MiB;
constexpr size_t WA_U = 108 * MiB, WA_PB = 172 * MiB, WA_Y = 236 * MiB;
constexpr size_t WB_WKV = 1 * MiB;
constexpr size_t WB_WQ = 13 * MiB;
constexpr size_t WB_WO = 25 * MiB;
constexpr size_t WB_WUP = 29 * MiB;
constexpr size_t WB_WDN = 51 * MiB;
constexpr size_t WB_H = 62 * MiB;
constexpr size_t WB_LSE = 94 * MiB;
constexpr size_t WB_KV = 97 * MiB;
constexpr size_t WB_Q = 289 * MiB;
constexpr size_t WB_AV = 289 * MiB;
constexpr size_t WB_H2 = 480 * MiB;
constexpr size_t WS_XTAIL = 128 * MiB;
constexpr size_t WS_HALO = 470 * MiB;
constexpr size_t WS_RAW0 = 474 * MiB;

__device__ __forceinline__ unsigned f2bf(float f) { unsigned u = __builtin_bit_cast(unsigned, f); return (u + 0x7fffu + ((u >> 16) & 1u)) >> 16; }
__device__ __forceinline__ unsigned cvt_pk_bf16(float lo, float hi) { unsigned r; asm volatile("v_cvt_pk_bf16_f32 %0, %1, %2" : "=v"(r) : "v"(lo), "v"(hi)); return r; }
__device__ __forceinline__ unsigned pk2(float lo, float hi) { unsigned r; asm("v_cvt_pk_bf16_f32 %0, %1, %2" : "=v"(r) : "v"(lo), "v"(hi)); return r; }
__device__ __forceinline__ float bflo(unsigned w) { return __builtin_bit_cast(float, w << 16); }
__device__ __forceinline__ float bfhi(unsigned w) { return __builtin_bit_cast(float, w & 0xffff0000u); }
__device__ __forceinline__ float wave_sum(float v) {
#pragma unroll
    for (int o = 1; o < 64; o <<= 1) v += __shfl_xor(v, o);
    return v;
}
#define LDS_WAIT() asm volatile("s_waitcnt lgkmcnt(0)" ::: "memory")

namespace pg8 {
constexpr int BM = 256, BK = 64, HALF = 128, HTB = HALF * BK * 2, STAGE_BYTES = 8 * HTB, NXCD = 8, WGM = 8;
__host__ __device__ __forceinline__ int lds_byte(int r, int c) { const int st = (r >> 4) * 2 + (c >> 5), rr = r & 15, cc = c & 31, ob = rr * 64 + cc * 2; return st * 1024 + (ob ^ (((ob >> 9) & 1) << 5)); }
__host__ __device__ __forceinline__ void stage_rc(int b, int& R, int& C) { const int st = b / 1024, sb = b % 1024, swz = sb ^ (((sb >> 9) & 1) << 5); R = (st >> 1) * 16 + swz / 64; C = (st & 1) * 32 + (swz % 64) / 2; }
__host__ __device__ __forceinline__ int perm32(int rho) { const int n = rho >> 4, i = rho & 15; return 8 * (i >> 2) + 4 * n + (i & 3); }

struct Unit { int pm, pn; };
struct Gemm { const bf16_t* A; const bf16_t* Bt; int M, N, K, lda, ldb, a_pn_koff; };

struct StaticOrder {
    int nM, nN, nwg, G, c;
    __device__ void init(int M, int N, int G_, int c_) { nM = M / BM; nN = N / BM; nwg = nM * nN; G = G_; c = c_; }
    __device__ bool next(int i, Unit& u) const {
        const long L = (long)i * G + c; if (L >= nwg) return false;
        int wgid = (int)L; { const int q = nwg / NXCD, r = nwg % NXCD, xcd = wgid % NXCD, off = wgid / NXCD; wgid = (xcd < r ? xcd * (q + 1) : r * (q + 1) + (xcd - r) * q) + off; }
        const int nig = WGM * nN, gid = wgid / nig, fm = gid * WGM, gsz = (nM - fm) < WGM ? (nM - fm) : WGM;
        u.pm = fm + ((wgid % nig) % gsz); u.pn = (wgid % nig) / gsz; return true;
    }
};

struct EpiBf16 {
    static constexpr bool PERM = true;
    bf16_t* O; int ldc; const float* cscale;
    __device__ __forceinline__ void operator()(const f32x4 (&acc)[2][2][4][2], const Unit& u, int wr, int wc, int fr, int fq) const {
        const int row0 = u.pm * BM + wr * 64 + fr; const int col0 = u.pn * BM + wc * 32 + 8 * fq;
        f32x4 sv[2][2];
#pragma unroll
        for (int bj = 0; bj < 2; ++bj)
#pragma unroll
            for (int n = 0; n < 2; ++n) sv[bj][n] = cscale ? *(const f32x4*)(cscale + col0 + bj * HALF + 4 * n) : (f32x4){1.f, 1.f, 1.f, 1.f};
#pragma unroll
        for (int ai = 0; ai < 2; ++ai)
#pragma unroll
            for (int m = 0; m < 4; ++m) { bf16_t* rowp = O + (size_t)(row0 + ai * HALF + m * 16) * ldc + col0;
#pragma unroll
                for (int bj = 0; bj < 2; ++bj) { const f32x4 v0 = acc[ai][bj][m][0] * sv[bj][0], v1 = acc[ai][bj][m][1] * sv[bj][1];
                    u32x4 w; w.x = cvt_pk_bf16(v0[0], v0[1]); w.y = cvt_pk_bf16(v0[2], v0[3]); w.z = cvt_pk_bf16(v1[0], v1[1]); w.w = cvt_pk_bf16(v1[2], v1[3]);
                    *(u32x4*)(rowp + bj * HALF) = w; } }
    }
};
struct EpiPoolU {
    static constexpr bool PERM = true;
    bf16_t* U; bf16_t* PB;
    __device__ __forceinline__ void operator()(const f32x4 (&acc)[2][2][4][2], const Unit& u, int wr, int wc, int fr, int fq) const {
        const int row0 = u.pm * BM + wr * 64 + fr; const int col0 = u.pn * BM + wc * 32 + 8 * fq;
#pragma unroll
        for (int ai = 0; ai < 2; ++ai)
#pragma unroll
            for (int m = 0; m < 4; ++m) { bf16_t* rowp = U + (size_t)(row0 + ai * HALF + m * 16) * DM + col0;
#pragma unroll
                for (int bj = 0; bj < 2; ++bj) { const f32x4 v0 = acc[ai][bj][m][0], v1 = acc[ai][bj][m][1];
                    u32x4 w; w.x = cvt_pk_bf16(v0[0], v0[1]); w.y = cvt_pk_bf16(v0[2], v0[3]); w.z = cvt_pk_bf16(v1[0], v1[1]); w.w = cvt_pk_bf16(v1[2], v1[3]);
                    *(u32x4*)(rowp + bj * HALF) = w; } }
        asm volatile("s_waitcnt vmcnt(0)" ::: "memory"); __builtin_amdgcn_s_barrier(); asm volatile("" ::: "memory");
        const int tid = ((wr * 4 + wc) * 64) + fq * 16 + fr, ch = tid & 31, seg = tid >> 5;
        if (seg >= 1) {
            const int w = 2 << u.pn, col = u.pn * BM + ch * 8; const size_t t0 = (size_t)u.pm * BM + seg * 16;
            const float inv = 1.f / (float)w;
            float sum[8];
#pragma unroll
            for (int e = 0; e < 8; ++e) sum[e] = 0.f;
            for (int j = 1; j <= w; ++j) { const u32x4 x = *(const u32x4*)(U + (t0 - j) * DM + col);
                sum[0] += bflo(x.x); sum[1] += bfhi(x.x); sum[2] += bflo(x.y); sum[3] += bfhi(x.y); sum[4] += bflo(x.z); sum[5] += bfhi(x.z); sum[6] += bflo(x.w); sum[7] += bfhi(x.w); }
            for (int i = 0; i < 16; ++i) { const size_t t = t0 + i;
                const u32x4 x = *(const u32x4*)(U + t * DM + col), y = *(const u32x4*)(U + (t - w) * DM + col);
                const float ut[8] = {bflo(x.x), bfhi(x.x), bflo(x.y), bfhi(x.y), bflo(x.z), bfhi(x.z), bflo(x.w), bfhi(x.w)};
                const float ul[8] = {bflo(y.x), bfhi(y.x), bflo(y.y), bfhi(y.y), bflo(y.z), bfhi(y.z), bflo(y.w), bfhi(y.w)};
                float o[8];
#pragma unroll
                for (int e = 0; e < 8; ++e) { sum[e] += ut[e] - ul[e]; o[e] = sum[e] * inv - ut[e]; }
                u32x4 wv; wv.x = cvt_pk_bf16(o[0], o[1]); wv.y = cvt_pk_bf16(o[2], o[3]); wv.z = cvt_pk_bf16(o[4], o[5]); wv.w = cvt_pk_bf16(o[6], o[7]);
                *(u32x4*)(PB + t * DM + col) = wv; }
        }
    }
};
struct EpiQKV {
    static constexpr bool PERM = true;
    bf16_t* O; size_t mat_stride; float scale;
    __device__ __forceinline__ void operator()(const f32x4 (&acc)[2][2][4][2], const Unit& u, int wr, int wc, int fr, int fq) const {
        const int colt = u.pn * BM; const int t = colt >> 10; const int g = t % 3; const int sh = 2 * g; const int dm1 = (1 << sh) - 1;
        const int hd0 = ((colt & 1023) >> 6) + (wc >> 1);
        bf16_t* base = O + (size_t)t * mat_stride + (size_t)hd0 * MC * 64 + (wc & 1) * 32 + 8 * fq;
        const int row0 = u.pm * BM + wr * 64 + fr;
#pragma unroll
        for (int ai = 0; ai < 2; ++ai)
#pragma unroll
            for (int m = 0; m < 4; ++m) { const int r = row0 + ai * HALF + m * 16; const int tt = r & 4095;
                const int dest = (r & ~4095) + ((tt & dm1) << (12 - sh)) + (tt >> sh);
                bf16_t* rowp = base + (size_t)dest * 64;
#pragma unroll
                for (int bj = 0; bj < 2; ++bj) { const f32x4 v0 = acc[ai][bj][m][0] * scale, v1 = acc[ai][bj][m][1] * scale;
                    u32x4 w; w.x = cvt_pk_bf16(v0[0], v0[1]); w.y = cvt_pk_bf16(v0[2], v0[3]); w.z = cvt_pk_bf16(v1[0], v1[1]); w.w = cvt_pk_bf16(v1[2], v1[3]);
                    *(u32x4*)(rowp + (size_t)bj * 2 * MC * 64) = w; } }
    }
};
template <bool BASE_F32>
struct EpiResid {
    static constexpr bool PERM = true;
    const float* base32; const bf16_t* base16; bf16_t* out; const float* gate; int row_base;
    __device__ __forceinline__ void operator()(const f32x4 (&acc)[2][2][4][2], const Unit& u, int wr, int wc, int fr, int fq) const {
        const int rowt = row_base + u.pm * BM; const int b = rowt >> 12;
        const int col0 = u.pn * BM + wc * 32 + 8 * fq; const int row0 = rowt + wr * 64 + fr;
        f32x4 gv[2][2];
#pragma unroll
        for (int bj = 0; bj < 2; ++bj)
#pragma unroll
            for (int n = 0; n < 2; ++n) gv[bj][n] = *(const f32x4*)(gate + (size_t)b * 6144 + col0 + bj * HALF + 4 * n);
        constexpr int NG = BASE_F32 ? 2 : 4;
#pragma unroll
        for (int rd = 0; rd < 8 / NG; ++rd) {
            u32x4 bw[NG][2]; f32x4 bf[BASE_F32 ? NG : 1][2][2];
#pragma unroll
            for (int mi = 0; mi < NG; ++mi) { const int gi = rd * NG + mi, ai = gi >> 2, m = gi & 3; const size_t off = (size_t)(row0 + ai * HALF + m * 16) * DM + col0;
#pragma unroll
                for (int bj = 0; bj < 2; ++bj) {
                    if (BASE_F32) { bf[BASE_F32 ? mi : 0][bj][0] = *(const f32x4*)(base32 + off + bj * HALF); bf[BASE_F32 ? mi : 0][bj][1] = *(const f32x4*)(base32 + off + bj * HALF + 4); }
                    else bw[mi][bj] = *(const u32x4*)(base16 + off + bj * HALF); } }
            asm volatile("" ::: "memory");
#pragma unroll
            for (int mi = 0; mi < NG; ++mi) { const int gi = rd * NG + mi, ai = gi >> 2, m = gi & 3; const size_t off = (size_t)(row0 + ai * HALF + m * 16) * DM + col0;
#pragma unroll
                for (int bj = 0; bj < 2; ++bj) {
                    f32x4 b0, b1;
                    if (BASE_F32) { b0 = bf[BASE_F32 ? mi : 0][bj][0]; b1 = bf[BASE_F32 ? mi : 0][bj][1]; }
                    else { const u32x4 w = bw[mi][bj]; b0 = (f32x4){bflo(w.x), bfhi(w.x), bflo(w.y), bfhi(w.y)}; b1 = (f32x4){bflo(w.z), bfhi(w.z), bflo(w.w), bfhi(w.w)}; }
                    const f32x4 v0 = b0 + gv[bj][0] * acc[ai][bj][m][0], v1 = b1 + gv[bj][1] * acc[ai][bj][m][1];
                    u32x4 w; w.x = cvt_pk_bf16(v0[0], v0[1]); w.y = cvt_pk_bf16(v0[2], v0[3]); w.z = cvt_pk_bf16(v1[0], v1[1]); w.w = cvt_pk_bf16(v1[2], v1[3]);
                    *(u32x4*)(out + off + bj * HALF) = w; } }
            asm volatile("" ::: "memory");
        }
    }
};

struct EpiConvGate {
    static constexpr bool PERM = true;
    bf16_t* G; const float* cw; const float* cb; float* halo; float* raw0; LAS float* xch;
    __device__ __forceinline__ void operator()(const f32x4 (&acc)[2][2][4][2], const Unit& u, int wr, int wc, int fr, int fq) const {
        const int lane = threadIdx.x & 63;
        const int colh = u.pn * 128 + wc * 32 + 8 * fq;
#define EA(ai, m, e) acc[ai][0][m][(e) >> 2][(e) & 3]
#define EV(ai, m, e) acc[ai][1][m][(e) >> 2][(e) & 3]
        if (fr >= 14) {
#pragma unroll
            for (int ai = 0; ai < 2; ++ai) { LAS float* xp = xch + ((((ai * 2 + wr) * 4 + wc) * 2 + (fr - 14)) * 4 + fq) * 8;
                *(LAS f32x4*)xp = acc[ai][0][3][0]; *(LAS f32x4*)(xp + 4) = acc[ai][0][3][1]; }
            if (wr == 1) { float* hp = halo + ((size_t)u.pm * 2 + (fr - 14)) * FF + colh; *(f32x4*)hp = acc[1][0][3][0]; *(f32x4*)(hp + 4) = acc[1][0][3][1]; }
        }
        asm volatile("s_waitcnt lgkmcnt(0)" ::: "memory"); __builtin_amdgcn_s_barrier(); asm volatile("" ::: "memory");
        f32x4 w0[2], w1[2], w2[2], bb[2];
#pragma unroll
        for (int nh = 0; nh < 2; ++nh) { const int colq = colh + 4 * nh; w0[nh] = *(const f32x4*)(cw + colq); w1[nh] = *(const f32x4*)(cw + FF + colq); w2[nh] = *(const f32x4*)(cw + 2 * FF + colq); bb[nh] = *(const f32x4*)(cb + colq); }
#pragma unroll
        for (int ai = 0; ai < 2; ++ai) {
            f32x4 q1[2], q2[2];
            const bool seam = (ai == 0 && wr == 0);
            if (!seam) { const int pai = wr == 1 ? ai : 0, pwr = wr == 1 ? 0 : 1; const LAS float* xp = xch + ((((pai * 2 + pwr) * 4 + wc) * 2) * 4 + fq) * 8;
#pragma unroll
                for (int nh = 0; nh < 2; ++nh) { const f32x4 p14 = *(const LAS f32x4*)(xp + 4 * nh), p15 = *(const LAS f32x4*)(xp + 32 + 4 * nh); q1[nh] = p15; q2[nh] = (fr == 1) ? p15 : p14; } }
            else { q1[0] = (f32x4){0.f, 0.f, 0.f, 0.f}; q1[1] = q1[0]; q2[0] = q1[0]; q2[1] = q1[0]; }
#pragma unroll
            for (int m = 0; m < 4; ++m) {
                u32x4 wout;
#pragma unroll
                for (int nh = 0; nh < 2; ++nh) {
                    const f32x4 av = acc[ai][0][m][nh], vv = acc[ai][1][m][nh];
                    f32x4 o;
#pragma unroll
                    for (int e = 0; e < 4; ++e) {
                        const float ac = av[e];
                        const float c1 = __builtin_bit_cast(float, __builtin_amdgcn_mov_dpp(__builtin_bit_cast(int, ac), 0x121, 0xF, 0xF, true));
                        const float c2 = __builtin_bit_cast(float, __builtin_amdgcn_mov_dpp(__builtin_bit_cast(int, ac), 0x122, 0xF, 0xF, true));
                        const float pr1 = fr >= 1 ? c1 : q1[nh][e];
                        const float pr2 = fr >= 2 ? c2 : q2[nh][e];
                        const float y = __builtin_fmaf(w2[nh][e], ac, __builtin_fmaf(w1[nh][e], pr1, __builtin_fmaf(w0[nh][e], pr2, bb[nh][e])));
                        o[e] = y * __builtin_amdgcn_rcpf(1.f + __builtin_amdgcn_exp2f(-LOG2E * y)) * vv[e];
                        q1[nh][e] = c1; q2[nh][e] = c2;
                    }
                    if (nh == 0) { wout.x = cvt_pk_bf16(o[0], o[1]); wout.y = cvt_pk_bf16(o[2], o[3]); } else { wout.z = cvt_pk_bf16(o[0], o[1]); wout.w = cvt_pk_bf16(o[2], o[3]); }
                }
                const int trow = ai * HALF + wr * 64 + m * 16 + fr;
                if (seam && m == 0 && fr < 2) {
                    float* rp = raw0 + ((size_t)u.pm * 2 + fr) * NUP + colh;
                    *(f32x4*)rp = acc[0][0][0][0]; *(f32x4*)(rp + 4) = acc[0][0][0][1]; *(f32x4*)(rp + FF) = acc[0][1][0][0]; *(f32x4*)(rp + FF + 4) = acc[0][1][0][1];
                } else *(u32x4*)(G + (size_t)(u.pm * BM + trow) * FF + colh) = wout;
            }
        }
#undef EA
#undef EV
    }
};

template <class Epi, class Sched>
__device__ __forceinline__ void gemm_phase(LAS unsigned char* lds, const Gemm g, const Sched& S, const Epi& E) {
    int tid_ = threadIdx.x; asm volatile("" : "+v"(tid_));
    const int tid = tid_, wid = __builtin_amdgcn_readfirstlane(tid >> 6), lane = tid & 63, wr = wid >> 2, wc = wid & 3, fr = lane & 15, fq = lane >> 4;
    const int K = g.K, nt = K / BK;
    unsigned voffA[2], voffB[2];
#pragma unroll
    for (int i = 0; i < 2; ++i) { int R, C; stage_rc(tid * 16 + i * 8192, R, C); const int Rb = Epi::PERM ? ((R & ~31) + perm32(R & 31)) : R;
        voffA[i] = (unsigned)(R * g.lda + C) * 2u; voffB[i] = (unsigned)(Rb * g.ldb + C) * 2u; }
    const size_t kstep = (size_t)(BK * 2);
    const size_t hstepA = (size_t)HALF * g.lda * 2, hstepB = (size_t)HALF * g.ldb * 2;
    const size_t tstepA = 2 * hstepA, tstepB = 2 * hstepB;
    const unsigned ldsw = (unsigned)wid * 1024u;
    const int aoff = lds_byte(wr * 64 + fr, fq * 8), boff = lds_byte(wc * 32 + fr, fq * 8);
#define PG8_SA(b, h) (((b) * 2 + (h)) * HTB)
#define PG8_SB(b, h) ((4 + (b) * 2 + (h)) * HTB)
#define PG8_STAGE(bufoff, gbase, voff) do { _Pragma("unroll") for (int _i = 0; _i < 2; ++_i) \
        __builtin_amdgcn_global_load_lds((const unsigned*)((const char*)(gbase) + (voff)[_i]), (LAS unsigned*)(lds + (bufoff) + ldsw + _i * 8192), 16, 0, 0); } while (0)
#define PG8_LDA(dst, b, h) do { _Pragma("unroll") for (int m = 0; m < 4; ++m) _Pragma("unroll") for (int k = 0; k < 2; ++k) dst[m][k] = *(const LAS bf16x8*)(lds + PG8_SA(b, h) + aoff + m * 2048 + k * 1024); } while (0)
#define PG8_LDB(dst, b, h) do { _Pragma("unroll") for (int n = 0; n < 2; ++n) _Pragma("unroll") for (int k = 0; k < 2; ++k) dst[n][k] = *(const LAS bf16x8*)(lds + PG8_SB(b, h) + boff + n * 2048 + k * 1024); } while (0)
#define PG8_MMA(ai, bj, At, Bt) do { __builtin_amdgcn_s_setprio(3); _Pragma("unroll") for (int m = 0; m < 4; ++m) _Pragma("unroll") for (int n = 0; n < 2; ++n) _Pragma("unroll") for (int k = 0; k < 2; ++k) \
        acc[ai][bj][m][n] = __builtin_amdgcn_mfma_f32_16x16x32_bf16(Bt[n][k], At[m][k], acc[ai][bj][m][n], 0, 0, 0); __builtin_amdgcn_s_setprio(0); } while (0)
#define PG8_WAIT_V(n) asm volatile("s_waitcnt vmcnt(" #n ")" ::: "memory")
#define PG8_WAIT_L(n) asm volatile("s_waitcnt lgkmcnt(" #n ")" ::: "memory")
#define PG8_BAR __builtin_amdgcn_s_barrier()
#define PG8_SCHED __builtin_amdgcn_sched_barrier(0)
#define PG8_BASEA(un) ((const char*)g.A + (size_t)(un).pm * tstepA + (size_t)(un).pn * (size_t)g.a_pn_koff * 2)
#define PG8_BASEB(un) ((const char*)g.Bt + (size_t)(un).pn * tstepB)
    Unit cur, nxt; int ui = 0;
    if (!S.next(0, cur)) return;
    f32x4 acc[2][2][4][2];
#pragma unroll
    for (int a = 0; a < 2; ++a)
#pragma unroll
        for (int b = 0; b < 2; ++b)
#pragma unroll
            for (int m = 0; m < 4; ++m)
#pragma unroll
                for (int n = 0; n < 2; ++n) acc[a][b][m][n] = (f32x4){0.f, 0.f, 0.f, 0.f};
    bf16x8 At[4][2], B0[2][2], B1[2][2];
    const char* cA = PG8_BASEA(cur); const char* cB = PG8_BASEB(cur);
    PG8_STAGE(PG8_SB(0, 0), cB, voffB); PG8_STAGE(PG8_SB(0, 1), cB + hstepB, voffB); PG8_STAGE(PG8_SA(0, 0), cA, voffA); PG8_STAGE(PG8_SA(0, 1), cA + hstepA, voffA);
    if (wr == 1) PG8_BAR;
    PG8_WAIT_V(2); PG8_BAR;
    PG8_STAGE(PG8_SB(1, 0), cB + kstep, voffB); PG8_STAGE(PG8_SA(1, 0), cA + kstep, voffA); PG8_STAGE(PG8_SB(1, 1), cB + hstepB + kstep, voffB);
    PG8_WAIT_V(6); PG8_BAR;
    for (;;) {
        const bool has_next = S.next(ui + 1, nxt);
        const char* nA = has_next ? PG8_BASEA(nxt) : cA; const char* nB = has_next ? PG8_BASEB(nxt) : cB;
        for (int t = 0; t < nt; t += 2) {
            const bool last = (t == nt - 2);
            const char* a1 = cA + (size_t)(t + 1) * kstep;
            const char* a2 = last ? nA : cA + (size_t)(t + 2) * kstep; const char* b2 = last ? nB : cB + (size_t)(t + 2) * kstep;
            const char* a3 = a2 + kstep; const char* b3 = b2 + kstep;
            PG8_LDB(B0, 0, 0); PG8_LDB(B1, 0, 1); PG8_SCHED; PG8_LDA(At, 0, 0); PG8_STAGE(PG8_SA(1, 1), a1 + hstepA, voffA);
            PG8_WAIT_V(8); PG8_WAIT_L(0); PG8_BAR; PG8_MMA(0, 0, At, B0); PG8_MMA(0, 1, At, B1); PG8_BAR; PG8_SCHED;
            PG8_LDA(At, 0, 1); PG8_STAGE(PG8_SB(0, 0), b2, voffB); PG8_STAGE(PG8_SB(0, 1), b2 + hstepB, voffB); PG8_STAGE(PG8_SA(0, 0), a2, voffA);
            PG8_WAIT_V(8); PG8_WAIT_L(0); PG8_BAR; PG8_MMA(1, 0, At, B0); PG8_MMA(1, 1, At, B1); PG8_BAR; PG8_SCHED;
            PG8_LDB(B0, 1, 0); PG8_LDB(B1, 1, 1); PG8_SCHED; PG8_LDA(At, 1, 0); PG8_STAGE(PG8_SA(0, 1), a2 + hstepA, voffA);
            PG8_WAIT_V(8); PG8_WAIT_L(0); PG8_BAR; PG8_MMA(0, 0, At, B0); PG8_MMA(0, 1, At, B1); PG8_BAR; PG8_SCHED;
            PG8_LDA(At, 1, 1); PG8_STAGE(PG8_SB(1, 0), b3, voffB); PG8_STAGE(PG8_SB(1, 1), b3 + hstepB, voffB); PG8_STAGE(PG8_SA(1, 0), a3, voffA);
            PG8_WAIT_V(8); PG8_WAIT_L(0); PG8_BAR; PG8_MMA(1, 0, At, B0); PG8_MMA(1, 1, At, B1); PG8_BAR; PG8_SCHED;
        }
        if (wr == 0) PG8_BAR;
        E(acc, cur, wr, wc, fr, fq);
        if (!has_next) break;
#pragma unroll
        for (int a = 0; a < 2; ++a)
#pragma unroll
            for (int b = 0; b < 2; ++b)
#pragma unroll
                for (int m = 0; m < 4; ++m)
#pragma unroll
                    for (int n = 0; n < 2; ++n) acc[a][b][m][n] = (f32x4){0.f, 0.f, 0.f, 0.f};
        cur = nxt; cA = nA; cB = nB; ++ui;
        if (wr == 1) PG8_BAR;
    }
    PG8_WAIT_V(0);
    PG8_BAR;
#undef PG8_SA
#undef PG8_SB
#undef PG8_STAGE
#undef PG8_LDA
#undef PG8_LDB
#undef PG8_MMA
#undef PG8_WAIT_V
#undef PG8_WAIT_L
#undef PG8_BAR
#undef PG8_SCHED
#undef PG8_BASEA
#undef PG8_BASEB
}
}

struct Ctx { LAS unsigned char* lds; int tid, lane, wave, bid, G; };
__device__ __forceinline__ Ctx relaunder(const Ctx& F0) { Ctx F = F0; int t = threadIdx.x; asm volatile("" : "+v"(t)); F.tid = t; F.lane = t & 63; F.wave = __builtin_amdgcn_readfirstlane(t >> 6); return F; }

template <bool AVPERM>
__device__ __forceinline__ void transpose_item(const float* W, int K, int N, bf16_t* WT, int row_off, LAS float* scr, int item, int lane) {
    const int nblk = N / 32, kb = item / nblk, nb = item % nblk, k0 = 64 * kb, n0 = 32 * nb;
    const int d0 = AVPERM ? (n0 < FF ? (n0 >> 7) * 256 + (n0 & 127) : ((n0 - FF) >> 7) * 256 + 128 + ((n0 - FF) & 127)) : n0;
    float wv[32];
#pragma unroll
    for (int i = 0; i < 32; ++i) { const int kk = 2 * i + (lane >> 5); wv[i] = W[(size_t)(k0 + kk) * N + n0 + (lane & 31)]; }
#pragma unroll
    for (int i = 0; i < 32; ++i) { const int kk = 2 * i + (lane >> 5); scr[kk * 33 + (lane & 31)] = wv[i]; }
    LDS_WAIT(); asm volatile("" ::: "memory");
    const int c = lane & 7;
#pragma unroll
    for (int j = 0; j < 4; ++j) { const int n = (lane >> 3) + 8 * j; const LAS float* s = scr + (8 * c) * 33 + n;
        u32x4 o; o.x = pk2(s[0 * 33], s[1 * 33]); o.y = pk2(s[2 * 33], s[3 * 33]); o.z = pk2(s[4 * 33], s[5 * 33]); o.w = pk2(s[6 * 33], s[7 * 33]);
        *(u32x4*)(WT + (size_t)(row_off + d0 + n) * K + k0 + 8 * c) = o; }
    LDS_WAIT(); asm volatile("" ::: "memory");
}
template <bool AVPERM = false>
__device__ __forceinline__ void transpose_matrix(const Ctx& F0, const float* W, int K, int N, bf16_t* WT, int row_off) {
    const Ctx F = relaunder(F0);
    LAS float* scr = (LAS float*)(F.lds + F.wave * 16384);
    const int gw = F.bid * NWAVES + F.wave, NGW = F.G * NWAVES, items = (K / 64) * (N / 32);
    for (int it = gw; it < items; it += NGW) transpose_item<AVPERM>(W, K, N, WT, row_off, scr, it, F.lane);
}

__device__ __forceinline__ void unpack8(const u32x4 w, float (&f)[8]) { f[0] = bflo(w.x); f[1] = bfhi(w.x); f[2] = bflo(w.y); f[3] = bfhi(w.y); f[4] = bflo(w.z); f[5] = bfhi(w.z); f[6] = bflo(w.w); f[7] = bfhi(w.w); }
__device__ __forceinline__ u32x4 pack8(const float (&f)[8]) { u32x4 w; w.x = pk2(f[0], f[1]); w.y = pk2(f[2], f[3]); w.z = pk2(f[4], f[5]); w.w = pk2(f[6], f[7]); return w; }

__device__ __forceinline__ void fold_pool_weights(const Ctx& F0, const float* wgrp, const float* pscale, const float* wout, bf16_t* WT) {
    const Ctx F = relaunder(F0);
    LAS float* WgS = (LAS float*)F.lds;
    LAS float* WoS = WgS + 4096;
    __syncthreads();
    for (int t = F.bid; t < 512; t += F.G) {
        const int L = t >> 8, kt = (t >> 4) & 15, nt = t & 15, k0 = kt * 64, n0 = nt * 64, g = k0 >> 8;
        const float* Wg = wgrp + (size_t)(L * 4 + g) * 65536 + (size_t)(k0 & 255) * 256;
        const float* Wo = wout + (size_t)L * DM * DM + (size_t)(g * 256) * DM + n0;
        const float* sc = pscale + L * DM + g * 256;
        const int n = F.tid & 63, kg = F.tid >> 6;
        float acc[8];
#pragma unroll
        for (int e = 0; e < 8; ++e) acc[e] = 0.f;
        for (int j0 = 0; j0 < 256; j0 += 64) {
#pragma unroll
            for (int i = 0; i < 8; ++i) { const int idx = F.tid + NTHREADS * i, r = idx >> 6, c = idx & 63;
                WgS[r * 64 + c] = Wg[(size_t)r * 256 + j0 + c];
                WoS[r * 64 + c] = Wo[(size_t)(j0 + r) * DM + c] * sc[j0 + r]; }
            __syncthreads();
#pragma unroll 8
            for (int j = 0; j < 64; ++j) { const float b = WoS[j * 64 + n];
#pragma unroll
                for (int e = 0; e < 8; ++e) acc[e] += WgS[(8 * kg + e) * 64 + j] * b; }
            __syncthreads();
        }
        *(u32x4*)(WT + (size_t)L * DM * DM + (size_t)(n0 + n) * DM + k0 + 8 * kg) = pack8(acc);
    }
}

__device__ __forceinline__ void mod_phase(const Ctx& F0, const float* c, const float* ada_w, const float* ada_b, const float* kv_ada_w, const float* kv_ada_b, float* mod, float* kvmod) {
    const Ctx F = relaunder(F0);
    LAS float* condT = (LAS float*)(F.lds + 131072 - 49152);
    LAS float* part = condT + 8192;
    __syncthreads();
    for (int i = F.tid; i < 8192; i += NTHREADS) { const int b = i >> 10, k = i & 1023; const float v = c[i]; condT[k * 8 + b] = v / (1.f + __expf(-v)); }
    __syncthreads();
    for (int it = F.bid; it < 416; it += F.G) {
        const float* W; const float* bias; float* outp; int N, cb;
        if (it < 384) { const int L = it / 96; cb = it % 96; W = ada_w + (size_t)L * 1024 * 6144; N = 6144; bias = ada_b + L * 6144; outp = mod + (size_t)L * 8 * 6144; }
        else { cb = it - 384; W = kv_ada_w; N = 2048; bias = kv_ada_b; outp = kvmod; }
        const int cl = F.tid & 63, kq = F.tid >> 6, col = cb * 64 + cl;
        float a0 = 0.f, a1 = 0.f, a2 = 0.f, a3 = 0.f, a4 = 0.f, a5 = 0.f, a6 = 0.f, a7 = 0.f;
#pragma unroll 16
        for (int k = kq * 128; k < kq * 128 + 128; ++k) {
            const float w = W[(size_t)k * N + col]; const f32x4 c0 = *(const LAS f32x4*)(condT + k * 8), c1 = *(const LAS f32x4*)(condT + k * 8 + 4);
            a0 += w * c0[0]; a1 += w * c0[1]; a2 += w * c0[2]; a3 += w * c0[3]; a4 += w * c1[0]; a5 += w * c1[1]; a6 += w * c1[2]; a7 += w * c1[3];
        }
        part[(kq * 8 + 0) * 64 + cl] = a0; part[(kq * 8 + 1) * 64 + cl] = a1; part[(kq * 8 + 2) * 64 + cl] = a2; part[(kq * 8 + 3) * 64 + cl] = a3;
        part[(kq * 8 + 4) * 64 + cl] = a4; part[(kq * 8 + 5) * 64 + cl] = a5; part[(kq * 8 + 6) * 64 + cl] = a6; part[(kq * 8 + 7) * 64 + cl] = a7;
        __syncthreads();
        { const int b = F.tid >> 6; float s = bias[cb * 64 + cl];
#pragma unroll
          for (int q = 0; q < 8; ++q) s += part[(q * 8 + b) * 64 + cl];
          outp[(size_t)b * N + cb * 64 + cl] = s; }
        __syncthreads();
    }
}

template <bool XBF16>
__device__ __forceinline__ void norm_phase(const Ctx& F0, const void* Xv, bf16_t* H, const float* g, const float* shift, const float* scale, int bstride, int row0, int nrows) {
    const Ctx F = relaunder(F0);
    const int gw = F.bid * NWAVES + F.wave, NGW = F.G * NWAVES;
    const int rpw = (nrows + NGW - 1) / NGW;
    int r = row0 + gw * rpw; const int rend = min(row0 + nrows, r + rpw);
    int curb = -1; f32x4 gs[4], shv[4];
    for (; r < rend; ++r) {
        const int b = r >> 12;
        if (b != curb) { curb = b;
#pragma unroll
            for (int j = 0; j < 4; ++j) { const int col = 4 * F.lane + 256 * j; const f32x4 gg = *(const f32x4*)(g + col), sc = *(const f32x4*)(scale + (size_t)b * bstride + col);
                gs[j] = gg * (sc + 1.f); shv[j] = *(const f32x4*)(shift + (size_t)b * bstride + col); } }
        f32x4 v[4]; float ss = 0.f;
        if (XBF16) { const u32x2* xr = (const u32x2*)((const bf16_t*)Xv + (size_t)r * DM) + F.lane;
#pragma unroll
            for (int j = 0; j < 4; ++j) { const u32x2 w = xr[64 * j]; v[j] = (f32x4){bflo(w.x), bfhi(w.x), bflo(w.y), bfhi(w.y)}; } }
        else { const f32x4* xr = (const f32x4*)((const float*)Xv + (size_t)r * DM) + F.lane;
#pragma unroll
            for (int j = 0; j < 4; ++j) v[j] = xr[64 * j]; }
#pragma unroll
        for (int j = 0; j < 4; ++j) ss += (v[j].x * v[j].x + v[j].y * v[j].y) + (v[j].z * v[j].z + v[j].w * v[j].w);
        const float rstd = 1.f / sqrtf(wave_sum(ss) * (1.f / DM) + EPS);
        u32x2* o8 = (u32x2*)(H + (size_t)(r - row0) * DM) + F.lane;
#pragma unroll
        for (int j = 0; j < 4; ++j) { const f32x4 y = v[j] * rstd * gs[j] + shv[j]; u32x2 w; w.x = pk2(y.x, y.y); w.y = pk2(y.z, y.w); o8[64 * j] = w; }
    }
}
__device__ __forceinline__ void final_norm_phase(const Ctx& F0, const bf16_t* Xs, int soff, float* out, const float* g, int r0, int r1) {
    const Ctx F = relaunder(F0);
    const int gw = F.bid * NWAVES + F.wave, NGW = F.G * NWAVES;
    f32x4 gs[4];
#pragma unroll
    for (int j = 0; j < 4; ++j) gs[j] = *(const f32x4*)(g + 4 * F.lane + 256 * j);
    for (int r = r0 + gw; r < r1; r += NGW) {
        const u32x2* xr = (const u32x2*)(Xs + (size_t)(r - soff) * DM) + F.lane;
        f32x4 v[4]; float ss = 0.f;
#pragma unroll
        for (int j = 0; j < 4; ++j) { const u32x2 w = xr[64 * j]; v[j] = (f32x4){bflo(w.x), bfhi(w.x), bflo(w.y), bfhi(w.y)}; ss += (v[j].x * v[j].x + v[j].y * v[j].y) + (v[j].z * v[j].z + v[j].w * v[j].w); }
        const float rstd = 1.f / sqrtf(wave_sum(ss) * (1.f / DM) + EPS);
        f32x4* orow = (f32x4*)(out + (size_t)r * DM) + F.lane;
#pragma unroll
        for (int j = 0; j < 4; ++j) orow[64 * j] = v[j] * rstd * gs[j];
    }
}
__device__ __forceinline__ void copy_rows_phase(const Ctx& F0, const bf16_t* src, bf16_t* dst, int nrows) {
    const Ctx F = relaunder(F0);
    const int gw = F.bid * NWAVES + F.wave, NGW = F.G * NWAVES;
    for (int r = gw; r < nrows; r += NGW) { const u32x4* s = (const u32x4*)(src + (size_t)r * DM) + F.lane; u32x4* d = (u32x4*)(dst + (size_t)r * DM) + F.lane; d[0] = s[0]; d[64] = s[64]; }
}
__device__ __forceinline__ void pool_phase(const Ctx& F0, const bf16_t* U, bf16_t* PB) {
    const Ctx F = relaunder(F0);
    const int nitems = (MTOT / 32) * 128;
    for (int it = F.bid * NTHREADS + F.tid; it < nitems; it += F.G * NTHREADS) {
        const int rb = it >> 7, ch = it & 127, t0 = rb * 32, col = ch * 8, w = 2 << (col >> 8), st0 = t0 & 4095;
        float sum[8];
#pragma unroll
        for (int e = 0; e < 8; ++e) sum[e] = 0.f;
        for (int j = 1; j <= w; ++j) if (st0 - j >= 0) { float f[8]; unpack8(*(const u32x4*)(U + (size_t)(t0 - j) * DM + col), f);
#pragma unroll
            for (int e = 0; e < 8; ++e) sum[e] += f[e]; }
        for (int i = 0; i < 32; ++i) {
            const int t = t0 + i, st = st0 + i; float ut[8]; unpack8(*(const u32x4*)(U + (size_t)t * DM + col), ut);
#pragma unroll
            for (int e = 0; e < 8; ++e) sum[e] += ut[e];
            if (st >= w) { float f[8]; unpack8(*(const u32x4*)(U + (size_t)(t - w) * DM + col), f);
#pragma unroll
                for (int e = 0; e < 8; ++e) sum[e] -= f[e]; }
            const float inv = 1.f / (float)min(st + 1, w); float o[8];
#pragma unroll
            for (int e = 0; e < 8; ++e) o[e] = sum[e] * inv - ut[e];
            *(u32x4*)(PB + (size_t)t * DM + col) = pack8(o);
        }
    }
}

template <class Sched>
__device__ __forceinline__ void pool_fix_units(const Ctx& F0, const Sched& S, const bf16_t* U, bf16_t* PB) {
    const Ctx F = relaunder(F0);
    pg8::Unit u;
    for (int i = 0; S.next(i, u); ++i) {
        const int ch = F.tid & 127, rq = F.tid >> 7, col = ch * 8, w = 2 << (col >> 8);
        const int t0 = u.pm * 256 + 4 * rq, st0 = t0 & 4095;
        float sum[8];
#pragma unroll
        for (int e = 0; e < 8; ++e) sum[e] = 0.f;
        for (int j = 1; j <= w; ++j) if (st0 - j >= 0) { float f[8]; unpack8(*(const u32x4*)(U + (size_t)(t0 - j) * DM + col), f);
#pragma unroll
            for (int e = 0; e < 8; ++e) sum[e] += f[e]; }
        for (int k = 0; k < 4; ++k) { const int t = t0 + k, st = st0 + k; float ut[8]; unpack8(*(const u32x4*)(U + (size_t)t * DM + col), ut);
#pragma unroll
            for (int e = 0; e < 8; ++e) sum[e] += ut[e];
            if (st >= w) { float f[8]; unpack8(*(const u32x4*)(U + (size_t)(t - w) * DM + col), f);
#pragma unroll
                for (int e = 0; e < 8; ++e) sum[e] -= f[e]; }
            const float inv = 1.f / (float)min(st + 1, w); float o[8];
#pragma unroll
            for (int e = 0; e < 8; ++e) o[e] = sum[e] * inv - ut[e];
            *(u32x4*)(PB + (size_t)t * DM + col) = pack8(o); }
    }
    asm volatile("s_waitcnt vmcnt(0)" ::: "memory");
    __syncthreads();
}

template <class Sched>
__device__ __forceinline__ void conv_fix_units(const Ctx& F0, const Sched& S, bf16_t* G, const float* cw, const float* cb, const float* halo, const float* raw0, int row0) {
    const Ctx F = relaunder(F0);
    pg8::Unit u;
    for (int i = 0; S.next(i, u); ++i) {
        const int tile = u.pm;
        if (F.tid < 352) {
            const int col = F.tid * 8;
            const bool seq0 = (((row0 + tile * 256) & 4095) == 0);
            float h254[8], h255[8];
#pragma unroll
            for (int e = 0; e < 8; ++e) { h254[e] = 0.f; h255[e] = 0.f; }
            if (!seq0) { const float* hp = halo + ((size_t)(tile - 1) * 2) * FF + col;
#pragma unroll
                for (int e = 0; e < 8; ++e) { h254[e] = hp[e]; h255[e] = hp[FF + e]; } }
            const float* rp = raw0 + ((size_t)tile * 2) * NUP + col;
            float o0[8], o1[8];
#pragma unroll
            for (int e = 0; e < 8; ++e) { const float a0 = rp[e], v0 = rp[FF + e], a1 = rp[NUP + e], v1 = rp[NUP + FF + e];
                const float w0 = cw[col + e], w1 = cw[FF + col + e], w2 = cw[2 * FF + col + e], bb = cb[col + e];
                const float y0 = bb + w0 * h254[e] + w1 * h255[e] + w2 * a0, y1 = bb + w0 * h255[e] + w1 * a0 + w2 * a1;
                o0[e] = y0 / (1.f + __expf(-y0)) * v0; o1[e] = y1 / (1.f + __expf(-y1)) * v1; }
            *(u32x4*)(G + (size_t)(tile * 256) * FF + col) = pack8(o0); *(u32x4*)(G + (size_t)(tile * 256 + 1) * FF + col) = pack8(o1);
        }
    }
    asm volatile("s_waitcnt vmcnt(0)" ::: "memory");
    __syncthreads();
}

__device__ __forceinline__ int crow(int r, int hi) { return (r & 3) + 8 * (r >> 2) + 4 * hi; }
__device__ __forceinline__ void attn_phase(const Ctx& F0, bf16_t* Qc, const bf16_t* KVc, float* LSE) {
    const Ctx F = relaunder(F0);
    LAS unsigned char* lds = F.lds;
    const int tid = F.tid, lane = F.lane, wid = F.wave, q = lane & 31, hi = lane >> 5;
    constexpr size_t MAT = (size_t)MC * 1024;
    constexpr int VOFF = 49152, NUNITS = 3072;
    const int q4 = (lane & 15) >> 2, p4 = lane & 3, dc16 = (lane >> 4) & 1;
    const int slot_l = tid >> 3, c_l = tid & 7;
    u32x4 kreg[6], vreg[6]; bf16x8 qn[4];
#define ATT_DECODE(u, h, rb, g, sh, prow0, has_prev) const int h = (u) & 15, rb = ((u) >> 4) & 63, g = (u) >> 10, sh = 2 * g, prow0 = rb * 256; const bool has_prev = ((prow0 & ((4096 >> sh) - 1)) != 0)
#define ATT_ISSUE(u) do { ATT_DECODE(u, h_, rb_, g_, sh_, prow0_, hp_); \
        const bf16_t* Kg_ = KVc + (size_t)g_ * MAT + (size_t)h_ * MC * 64 + c_l * 8; const bf16_t* Vg_ = KVc + (size_t)(3 + g_) * MAT + (size_t)h_ * MC * 64 + c_l * 8; \
        _Pragma("unroll") for (int i = 0; i < 6; ++i) if (hp_ || i >= 2) { const long prow = (long)prow0_ - 128 + slot_l + 64 * i; kreg[i] = *(const u32x4*)(Kg_ + prow * 64); vreg[i] = *(const u32x4*)(Vg_ + prow * 64); } \
        const bf16_t* Qw_ = Qc + (size_t)g_ * MAT + ((size_t)h_ * MC + prow0_ + 32 * wid + q) * 64; \
        _Pragma("unroll") for (int s = 0; s < 4; ++s) qn[s] = *(const bf16x8*)(Qw_ + 16 * s + 8 * hi); } while (0)
    int u = F.bid;
    if (u < NUNITS) ATT_ISSUE(u);
    while (u < NUNITS) {
        ATT_DECODE(u, h, rb, g, sh, prow0, has_prev);
        bf16_t* Qw = Qc + (size_t)g * MAT + ((size_t)h * MC + prow0 + 32 * wid + q) * 64;
        bf16x8 qf[4];
#pragma unroll
        for (int s = 0; s < 4; ++s) qf[s] = qn[s];
#pragma unroll
        for (int i = 0; i < 6; ++i) if (has_prev || i >= 2) { const int slot = slot_l + 64 * i;
            *(LAS u32x4*)(lds + slot * 128 + ((c_l ^ ((slot >> 1) & 7)) << 4)) = kreg[i];
            *(LAS u32x4*)(lds + VOFF + slot * 128 + ((c_l << 4) ^ (((slot >> 1) & 1) << 6))) = vreg[i]; }
        __syncthreads();
        const int un = u + F.G;
        if (un < NUNITS) ATT_ISSUE(un);
        const int ii = g * 16 + h; const float ee = ii < 32 ? 0.125f * (float)(ii + 1) : 4.0f + 0.25f * (float)(ii - 31);
        const float slope2 = exp2f(-ee) * (float)(1 << sh) * LOG2E;
        float mx = -INFINITY, lsum = 0.f;
        f32x16 o0 = {0.f, 0.f, 0.f, 0.f, 0.f, 0.f, 0.f, 0.f, 0.f, 0.f, 0.f, 0.f, 0.f, 0.f, 0.f, 0.f}, o1 = o0;
        f32x16 cf;
#pragma unroll
        for (int r = 0; r < 16; ++r) cf[r] = slope2 * (float)crow(r, hi);
        const int qq = q - 4 * hi;
        const int i0 = has_prev ? 0 : (wid < 4 ? 4 - wid : 0);
#define ATT_TILE(i, MASKLO, MASKHI) do { \
            const int sb = 32 * wid + 32 * (i); \
            const float base = -slope2 * (float)(q + 128 - 32 * (i)); \
            f32x16 a; \
            _Pragma("unroll") for (int r = 0; r < 16; ++r) a[r] = cf[r] + base; \
            { const int slot = sb + q; \
              _Pragma("unroll") for (int s = 0; s < 4; ++s) { const int c = 2 * s + hi; const bf16x8 kf = *(const LAS bf16x8*)(lds + slot * 128 + ((c ^ ((slot >> 1) & 7)) << 4)); \
                  a = __builtin_amdgcn_mfma_f32_32x32x16_bf16(kf, qf[s], a, 0, 0, 0); } } \
            if (MASKHI) { _Pragma("unroll") for (int r = 0; r < 16; ++r) if (crow(r, 0) > qq) a[r] = -INFINITY; }     \
            if (MASKLO) { _Pragma("unroll") for (int r = 0; r < 16; ++r) if (crow(r, 0) < qq) a[r] = -INFINITY; }     \
            float tmax = fmaxf(fmaxf(a[0], a[1]), fmaxf(a[2], a[3])); \
            _Pragma("unroll") for (int r = 4; r < 16; r += 4) tmax = fmaxf(tmax, fmaxf(fmaxf(a[r], a[r + 1]), fmaxf(a[r + 2], a[r + 3]))); \
            tmax = fmaxf(tmax, __shfl_xor(tmax, 32)); \
            if (__any(tmax > mx)) { const float mnew = fmaxf(mx, tmax); const float alpha = __builtin_amdgcn_exp2f(mx - mnew); mx = mnew; lsum *= alpha; \
                _Pragma("unroll") for (int r = 0; r < 16; ++r) { o0[r] *= alpha; o1[r] *= alpha; } } \
            float ps = 0.f; \
            _Pragma("unroll") for (int r = 0; r < 16; ++r) { const float p = __builtin_amdgcn_exp2f(a[r] - mx); a[r] = p; ps += p; } \
            lsum += ps; \
            _Pragma("unroll") for (int s2 = 0; s2 < 2; ++s2) { \
                u32x4 pw; pw.x = cvt_pk_bf16(a[8 * s2 + 0], a[8 * s2 + 1]); pw.y = cvt_pk_bf16(a[8 * s2 + 2], a[8 * s2 + 3]); \
                pw.z = cvt_pk_bf16(a[8 * s2 + 4], a[8 * s2 + 5]); pw.w = cvt_pk_bf16(a[8 * s2 + 6], a[8 * s2 + 7]); \
                const bf16x8 pf = __builtin_bit_cast(bf16x8, pw); \
                const int slotA = sb + 16 * s2 + 4 * hi + q4; \
                _Pragma("unroll") for (int dh = 0; dh < 2; ++dh) { \
                    const int colb = (32 * dh + 16 * dc16 + 4 * p4) * 2; \
                    const int addr = VOFF + slotA * 128 + (colb ^ (((slotA >> 1) & 1) << 6)); \
                    const s16x4 lo = __builtin_bit_cast(s16x4, __builtin_amdgcn_ds_read_tr16_b64_v4i16((LAS s16x4*)(lds + addr))); \
                    const s16x4 hh = __builtin_bit_cast(s16x4, __builtin_amdgcn_ds_read_tr16_b64_v4i16((LAS s16x4*)(lds + addr + 1024))); \
                    const bf16x8 vf = (bf16x8){lo[0], lo[1], lo[2], lo[3], hh[0], hh[1], hh[2], hh[3]}; \
                    if (dh == 0) o0 = __builtin_amdgcn_mfma_f32_32x32x16_bf16(vf, pf, o0, 0, 0, 0); \
                    else o1 = __builtin_amdgcn_mfma_f32_32x32x16_bf16(vf, pf, o1, 0, 0, 0); } } \
        } while (0)
        ATT_TILE(4, false, true);
        for (int i = 3; i >= 1 && i >= i0; --i) ATT_TILE(i, false, false);
        if (i0 == 0) ATT_TILE(0, true, false);
#undef ATT_TILE
        lsum += __shfl_xor(lsum, 32);
        const float inv = 1.f / lsum;
#pragma unroll
        for (int rq = 0; rq < 4; ++rq) {
            u32x2 w0; w0.x = cvt_pk_bf16(o0[4 * rq + 0] * inv, o0[4 * rq + 1] * inv); w0.y = cvt_pk_bf16(o0[4 * rq + 2] * inv, o0[4 * rq + 3] * inv);
            u32x2 w1; w1.x = cvt_pk_bf16(o1[4 * rq + 0] * inv, o1[4 * rq + 1] * inv); w1.y = cvt_pk_bf16(o1[4 * rq + 2] * inv, o1[4 * rq + 3] * inv);
            *(u32x2*)(Qw + 8 * rq + 4 * hi) = w0; *(u32x2*)(Qw + 32 + 8 * rq + 4 * hi) = w1;
        }
        if (hi == 0) LSE[((size_t)g * MC + prow0 + 32 * wid + q) * 16 + h] = mx + log2f(lsum);
        __syncthreads();
        u = un;
    }
#undef ATT_DECODE
#undef ATT_ISSUE
}
__device__ __forceinline__ void merge_phase(const Ctx& F0, const bf16_t* Oc, const float* LSE, bf16_t* OM) {
    const Ctx F = relaunder(F0);
    const int gw = F.bid * NWAVES + F.wave, NGW = F.G * NWAVES;
    constexpr size_t MAT = (size_t)MC * 1024;
    const int col = F.lane * 16, h = F.lane >> 2;
    for (int r = gw; r < MC; r += NGW) {
        const int tt = r & 4095, bb = r & ~4095;
        int pr[3]; float l[3];
#pragma unroll
        for (int g = 0; g < 3; ++g) { const int sh = 2 * g; pr[g] = bb + ((tt & ((1 << sh) - 1)) << (12 - sh)) + (tt >> sh); l[g] = LSE[((size_t)g * MC + pr[g]) * 16 + h]; }
        const float mx = fmaxf(l[0], fmaxf(l[1], l[2]));
        float w[3]; w[0] = exp2f(l[0] - mx); w[1] = exp2f(l[1] - mx); w[2] = exp2f(l[2] - mx);
        const float inv = 1.f / (w[0] + w[1] + w[2]);
        float acc[16];
#pragma unroll
        for (int e = 0; e < 16; ++e) acc[e] = 0.f;
#pragma unroll
        for (int g = 0; g < 3; ++g) { const bf16_t* p = Oc + (size_t)g * MAT + ((size_t)h * MC + pr[g]) * 64 + (F.lane & 3) * 16; float f0[8], f1[8]; unpack8(*(const u32x4*)p, f0); unpack8(*(const u32x4*)(p + 8), f1);
            const float wg = w[g] * inv;
#pragma unroll
            for (int e = 0; e < 8; ++e) { acc[e] += wg * f0[e]; acc[8 + e] += wg * f1[e]; } }
        float o0[8], o1[8];
#pragma unroll
        for (int e = 0; e < 8; ++e) { o0[e] = acc[e]; o1[e] = acc[8 + e]; }
        bf16_t* op = OM + (size_t)r * DM + col; *(u32x4*)op = pack8(o0); *(u32x4*)(op + 8) = pack8(o1);
    }
}

#define XB_TMO      128
#define XB_XCNT(j)  (256  + 64 * (j))
#define XB_XSUB(j)  (1280 + 64 * (j))
#define XB_XGEN(j)  (2304 + 64 * (j))
#define XB_TOP      3328
#define XB_TOPGEN   3392
#define XCD_BAR_WORDS 3456
#define XB_SPIN_CAP (1u << 18)
__device__ __forceinline__ unsigned xb_ld(unsigned* p)              { return __hip_atomic_load(p, __ATOMIC_RELAXED, __HIP_MEMORY_SCOPE_AGENT); }
__device__ __forceinline__ unsigned xb_add(unsigned* p, unsigned v) { return __hip_atomic_fetch_add(p, v, __ATOMIC_RELAXED, __HIP_MEMORY_SCOPE_AGENT); }
__device__ __forceinline__ unsigned xb_xcc_id() { return (unsigned)__builtin_amdgcn_s_getreg((3 << 11) | 20) & 0xFu; }
#define XB_SPIN(cond, bar) do { unsigned _sp = 0; while (cond) { __builtin_amdgcn_s_sleep(1); \
    if ((++_sp & 255u) == 0u) { if (xb_ld(&(bar)[XB_TMO])) break; if (_sp > XB_SPIN_CAP) { atomicAdd(&(bar)[XB_TMO], 1u); break; } } } } while (0)
struct XcdBarrier { unsigned* bar; unsigned x; volatile LAS unsigned* st; };
__device__ __forceinline__ XcdBarrier xcd_barrier_post(unsigned* bar, volatile LAS unsigned* st) {
    XcdBarrier b; b.bar = bar; b.x = xb_xcc_id(); b.st = st;
    if (threadIdx.x == 0) (void)xb_add(&bar[XB_XCNT(b.x)], 1u);
    return b;
}
__device__ __forceinline__ void xcd_barrier_complete(unsigned* bar, unsigned x, unsigned& nloc, unsigned& nx) {
    const unsigned G = gridDim.x * gridDim.y * gridDim.z;
    unsigned sum, cnt, mine, sp = 0u;
    for (;;) {
        sum = 0u; cnt = 0u; mine = 0u;
#pragma unroll
        for (unsigned j = 0; j < 16; ++j) { const unsigned c = xb_ld(&bar[XB_XCNT(j)]); sum += c; cnt += (c > 0u) ? 1u : 0u; mine = (j == x) ? c : mine; }
        if (sum == G) break;
        __builtin_amdgcn_s_sleep(1);
        if ((++sp & 255u) == 0u) { if (xb_ld(&bar[XB_TMO])) break; if (sp > XB_SPIN_CAP) { atomicAdd(&bar[XB_TMO], 1u); break; } }
    }
    nloc = mine > 0u ? mine : 1u; nx = cnt > 0u ? cnt : 1u;
}
__device__ __forceinline__ void xcd_barrier(const XcdBarrier& b) {
    asm volatile("s_waitcnt vmcnt(0)" ::: "memory");
    __syncthreads();
    int t0_ = threadIdx.x; asm volatile("" : "+v"(t0_));
    if (t0_ == 0) {
        unsigned* bar = b.bar; unsigned bx = b.x; asm volatile("" : "+s"(bx));
        __builtin_amdgcn_s_waitcnt(0);
        unsigned nloc = b.st[0], nx = b.st[1];
        if (nloc == 0u) { xcd_barrier_complete(bar, bx, nloc, nx); b.st[0] = nloc; b.st[1] = nx; }
        const unsigned old = xb_add(&bar[XB_XSUB(bx)], 1u);
        const unsigned gen = old / nloc;
        if (old + 1u == (gen + 1u) * nloc) {
            __builtin_amdgcn_fence(__ATOMIC_RELEASE, "agent");
            asm volatile("s_waitcnt vmcnt(0)" ::: "memory");
            const unsigned og = xb_add(&bar[XB_TOP], 1u);
            const unsigned tg = og / nx;
            if (og + 1u == (tg + 1u) * nx) xb_add(&bar[XB_TOPGEN], 1u);
            else XB_SPIN(xb_ld(&bar[XB_TOPGEN]) == tg, bar);
            __builtin_amdgcn_fence(__ATOMIC_ACQUIRE, "agent");
            xb_add(&bar[XB_XGEN(bx)], 1u);
            asm volatile("s_waitcnt vmcnt(0)" ::: "memory");
        } else {
            XB_SPIN(xb_ld(&bar[XB_XGEN(bx)]) == gen, bar);
            __builtin_amdgcn_fence(__ATOMIC_ACQUIRE, "agent");
            asm volatile("s_waitcnt vmcnt(0)" ::: "memory");
        }
    }
    __syncthreads();
}

struct Args { const float* in[21]; float* out; unsigned char* ws; };
enum { I_X = 0, I_C, I_ADAW, I_ADAB, I_N1G, I_N2G, I_PWIN, I_PWGRP, I_PSCALE, I_PWOUT, I_KVNG, I_KVADAW, I_KVADAB, I_WKV, I_WQ, I_WO, I_WUP, I_CONVW, I_CONVB, I_WDN, I_FING };

__global__ void __launch_bounds__(NTHREADS, 2) mega_fwd(Args a) {
    extern __shared__ __attribute__((aligned(16))) unsigned char lds_raw[];
    cg::grid_group grid = cg::this_grid();
    Ctx F; F.lds = (LAS unsigned char*)lds_raw; F.tid = threadIdx.x; F.lane = F.tid & 63; F.wave = __builtin_amdgcn_readfirstlane(F.tid >> 6); F.bid = blockIdx.x; F.G = gridDim.x;
    unsigned char* ws = a.ws;
    float* mod = (float*)(ws + WS_MOD); float* kvmod = (float*)(ws + WS_KVMOD);
    bf16_t* X = (bf16_t*)((unsigned char*)a.out + 64 * MiB);
    float* halo = (float*)(ws + WS_HALO); float* raw0 = (float*)(ws + WS_RAW0);
    LAS float* xch = (LAS float*)(F.lds + 131072 + 4096);
#define GSYNC_CG() do { asm volatile("s_waitcnt vmcnt(0)" ::: "memory"); grid.sync(); __builtin_amdgcn_fence(__ATOMIC_ACQUIRE, "agent"); } while (0)
#define GSYNC() xcd_barrier(bar)
    volatile LAS unsigned* MISC = (volatile LAS unsigned*)(F.lds + 131072 + 320);
    if (F.tid < 32) MISC[F.tid] = 0u;
    unsigned* barw = (unsigned*)(ws + WS_BAR);
    __syncthreads();

    for (int L = 0; L < 2; ++L) {
        transpose_matrix(F, a.in[I_PWIN] + (size_t)L * DM * DM, DM, DM, (bf16_t*)(ws + WA_WIN) + (size_t)L * DM * DM, 0);
        transpose_matrix<true>(F, a.in[I_WUP] + (size_t)L * DM * NUP, DM, NUP, (bf16_t*)(ws + WA_WUP) + (size_t)L * DM * NUP, 0);
        transpose_matrix(F, a.in[I_WDN] + (size_t)L * FF * DM, FF, DM, (bf16_t*)(ws + WA_WDN) + (size_t)L * FF * DM, 0);
    }
    fold_pool_weights(F, a.in[I_PWGRP], a.in[I_PSCALE], a.in[I_PWOUT], (bf16_t*)(ws + WA_WOUT));
    mod_phase(F, a.in[I_C], a.in[I_ADAW], a.in[I_ADAB], a.in[I_KVADAW], a.in[I_KVADAB], mod, kvmod);
    const XcdBarrier bar = xcd_barrier_post(barw, MISC + 8);
    if (a.ws == nullptr) GSYNC_CG();
    GSYNC();

    for (int L = 0; L < 2; ++L) {
        const float* modL = mod + (size_t)L * 8 * 6144;
        bf16_t* H = (bf16_t*)(ws + WA_H); bf16_t* U = (bf16_t*)(ws + WA_U); bf16_t* PB = (bf16_t*)(ws + WA_PB); bf16_t* AV = (bf16_t*)(ws + WA_AV);
        if (L == 0) norm_phase<false>(F, a.in[I_X], H, a.in[I_N1G] + L * DM, modL + 0, modL + 1024, 6144, 0, MTOT);
        else norm_phase<true>(F, X, H, a.in[I_N1G] + L * DM, modL + 0, modL + 1024, 6144, 0, MTOT);
        GSYNC();
        { pg8::Gemm g{H, (bf16_t*)(ws + WA_WIN) + (size_t)L * DM * DM, MTOT, DM, DM, DM, DM, 0}; pg8::StaticOrder S; S.init(MTOT, DM, F.G, F.bid);
          pg8::EpiPoolU E{U, PB}; pg8::gemm_phase(F.lds, g, S, E); }
        GSYNC();
        { pg8::Gemm g{PB, (bf16_t*)(ws + WA_WOUT) + (size_t)L * DM * DM, MTOT, DM, DM, DM, DM, 0}; pg8::StaticOrder S; S.init(MTOT, DM, F.G, F.bid);
          pool_fix_units(F, S, U, PB);
          if (L == 0) { pg8::EpiResid<true> E{a.in[I_X], nullptr, X, modL + 2048, 0}; pg8::gemm_phase(F.lds, g, S, E); }
          else { pg8::EpiResid<false> E{nullptr, X, X, modL + 2048, 0}; pg8::gemm_phase(F.lds, g, S, E); } }
        GSYNC();
        norm_phase<true>(F, X, H, a.in[I_N2G] + L * DM, modL + 3072, modL + 4096, 6144, 0, MTOT);
        GSYNC();
        { pg8::Gemm g{H, (bf16_t*)(ws + WA_WUP) + (size_t)L * DM * NUP, MTOT, NUP, DM, DM, DM, 0}; pg8::StaticOrder S; S.init(MTOT, NUP, F.G, F.bid);
          pg8::EpiConvGate E{AV, a.in[I_CONVW] + (size_t)L * 3 * FF, a.in[I_CONVB] + (size_t)L * FF, halo, raw0, xch}; pg8::gemm_phase(F.lds, g, S, E); }
        GSYNC();
        { pg8::Gemm g{AV, (bf16_t*)(ws + WA_WDN) + (size_t)L * FF * DM, MTOT, DM, FF, FF, FF, 0}; pg8::StaticOrder S; S.init(MTOT, DM, F.G, F.bid);
          conv_fix_units(F, S, AV, a.in[I_CONVW] + (size_t)L * 3 * FF, a.in[I_CONVB] + (size_t)L * FF, halo, raw0, 0);
          pg8::EpiResid<false> E{nullptr, X, X, modL + 5120, 0}; pg8::gemm_phase(F.lds, g, S, E); }
        GSYNC();
    }

    transpose_matrix(F, a.in[I_WKV], DM, 6144, (bf16_t*)(ws + WB_WKV), 0);
    for (int j = 0; j < 2; ++j) {
        transpose_matrix(F, a.in[I_WQ] + (size_t)j * DM * 3072, DM, 3072, (bf16_t*)(ws + WB_WQ) + (size_t)j * DM * 3072, 0);
        transpose_matrix(F, a.in[I_WO] + (size_t)j * DM * DM, DM, DM, (bf16_t*)(ws + WB_WO) + (size_t)j * DM * DM, 0);
        transpose_matrix<true>(F, a.in[I_WUP] + (size_t)(2 + j) * DM * NUP, DM, NUP, (bf16_t*)(ws + WB_WUP) + (size_t)j * DM * NUP, 0);
        transpose_matrix(F, a.in[I_WDN] + (size_t)(2 + j) * FF * DM, FF, DM, (bf16_t*)(ws + WB_WDN) + (size_t)j * FF * DM, 0);
    }
    __syncthreads();

    for (int c = 0; c < 2; ++c) {
        const int row0 = c * MC;
        bf16_t* H = (bf16_t*)(ws + WB_H); bf16_t* KVc = (bf16_t*)(ws + WB_KV); bf16_t* Qc = (bf16_t*)(ws + WB_Q); bf16_t* AV = (bf16_t*)(ws + WB_AV); float* LSE = (float*)(ws + WB_LSE);
        bf16_t* H2 = (bf16_t*)(ws + WB_H2);
        { const float* mod2 = mod + (size_t)2 * 8 * 6144;
          norm_phase<true>(F, X, H, a.in[I_KVNG], kvmod + 0, kvmod + 1024, 2048, row0, MC);
          norm_phase<true>(F, X, H2, a.in[I_N1G] + 2 * DM, mod2 + 0, mod2 + 1024, 6144, row0, MC); }
        GSYNC();
        { pg8::Gemm g{H, (bf16_t*)(ws + WB_WKV), MC, 6144, DM, DM, DM, 0}; pg8::StaticOrder S; S.init(MC, 6144, F.G, F.bid);
          pg8::EpiQKV E{KVc, (size_t)MC * 1024, 1.0f}; pg8::gemm_phase(F.lds, g, S, E); }
        { pg8::Gemm g{H2, (bf16_t*)(ws + WB_WQ), MC, 3072, DM, DM, DM, 0}; pg8::StaticOrder S; S.init(MC, 3072, F.G, F.bid);
          pg8::EpiQKV E{Qc, (size_t)MC * 1024, 0.125f * LOG2E}; pg8::gemm_phase(F.lds, g, S, E); }
        GSYNC();
        for (int j = 0; j < 2; ++j) {
            const int L = 2 + j; const float* modL = mod + (size_t)L * 8 * 6144;
            if (j == 1) {
                norm_phase<true>(F, X, H, a.in[I_N1G] + L * DM, modL + 0, modL + 1024, 6144, row0, MC);
                GSYNC();
                { pg8::Gemm g{H, (bf16_t*)(ws + WB_WQ) + (size_t)j * DM * 3072, MC, 3072, DM, DM, DM, 0}; pg8::StaticOrder S; S.init(MC, 3072, F.G, F.bid);
                  pg8::EpiQKV E{Qc, (size_t)MC * 1024, 0.125f * LOG2E}; pg8::gemm_phase(F.lds, g, S, E); }
                GSYNC();
            }
            attn_phase(F, Qc, KVc, LSE);
            GSYNC();
            merge_phase(F, Qc, LSE, H);
            GSYNC();
            { pg8::Gemm g{H, (bf16_t*)(ws + WB_WO) + (size_t)j * DM * DM, MC, DM, DM, DM, DM, 0}; pg8::StaticOrder S; S.init(MC, DM, F.G, F.bid);
              pg8::EpiResid<false> E{nullptr, X, X, modL + 2048, row0}; pg8::gemm_phase(F.lds, g, S, E); }
            GSYNC();
            norm_phase<true>(F, X, H, a.in[I_N2G] + L * DM, modL + 3072, modL + 4096, 6144, row0, MC);
            GSYNC();
            { pg8::Gemm g{H, (bf16_t*)(ws + WB_WUP) + (size_t)j * DM * NUP, MC, NUP, DM, DM, DM, 0}; pg8::StaticOrder S; S.init(MC, NUP, F.G, F.bid);
              pg8::EpiConvGate E{AV, a.in[I_CONVW] + (size_t)L * 3 * FF, a.in[I_CONVB] + (size_t)L * FF, halo, raw0, xch}; pg8::gemm_phase(F.lds, g, S, E); }
            GSYNC();
            { pg8::Gemm g{AV, (bf16_t*)(ws + WB_WDN) + (size_t)j * FF * DM, MC, DM, FF, FF, FF, 0}; pg8::StaticOrder S; S.init(MC, DM, F.G, F.bid);
              conv_fix_units(F, S, AV, a.in[I_CONVW] + (size_t)L * 3 * FF, a.in[I_CONVB] + (size_t)L * FF, halo, raw0, row0);
              bf16_t* Xo = (c == 1 && j == 1) ? (bf16_t*)(ws + WS_XTAIL) - (size_t)MC * DM : X;
              pg8::EpiResid<false> E{nullptr, X, Xo, modL + 5120, row0}; pg8::gemm_phase(F.lds, g, S, E); }
            GSYNC();
        }
    }
    final_norm_phase(F, X, 0, a.out, a.in[I_FING], 0, MC);
    GSYNC();
    final_norm_phase(F, (const bf16_t*)(ws + WS_XTAIL), MC, a.out, a.in[I_FING], MC, MTOT);
}

extern "C" void kernel_launch(void* const* d_in, const int* in_sizes, int n_in, void* d_out, int out_size, void* d_ws, size_t ws_size, hipStream_t stream) {
    static int grid = 0;
    if (grid == 0) {
        int dev = 0, cus = 0, per_cu = 0;
        if (n_in != 21 || out_size != MTOT * DM || ws_size < 512 * MiB) { fprintf(stderr, "kernel_launch: unexpected problem (n_in %d, out %d, ws %zu)\n", n_in, out_size, ws_size); grid = -1; return; }
        if (hipGetDevice(&dev) != hipSuccess || hipDeviceGetAttribute(&cus, hipDeviceAttributeMultiprocessorCount, dev) != hipSuccess) { grid = -1; return; }
        if (hipFuncSetAttribute((const void*)mega_fwd, hipFuncAttributeMaxDynamicSharedMemorySize, LDS_BYTES) != hipSuccess) { fprintf(stderr, "kernel_launch: hipFuncSetAttribute failed\n"); grid = -1; return; }
        if (hipOccupancyMaxActiveBlocksPerMultiprocessor(&per_cu, (const void*)mega_fwd, NTHREADS, LDS_BYTES) != hipSuccess || per_cu < 1) { fprintf(stderr, "kernel_launch: occupancy query says %d\n", per_cu); per_cu = 1; }
        (void)hipGetLastError();
        grid = cus;
    }
    if (grid < 0) return;
    Args a{};
    for (int i = 0; i < 21; ++i) a.in[i] = (const float*)d_in[i];
    a.out = (float*)d_out; a.ws = (unsigned char*)d_ws;
    if (hipMemsetAsync((unsigned char*)d_ws + WS_BAR, 0, XCD_BAR_WORDS * 4, stream) != hipSuccess) { fprintf(stderr, "kernel_launch: memset of the barrier words failed\n"); return; }
    void* args[] = {&a};
    hipError_t e = hipLaunchCooperativeKernel((const void*)mega_fwd, dim3(grid), dim3(NTHREADS), args, LDS_BYTES, stream);
    if (e != hipSuccess) fprintf(stderr, "kernel_launch: cooperative launch failed: %s (grid %d)\n", hipGetErrorString(e), grid);
}
```

```cpp
#include <hip/hip_runtime.h>
#include <hip/hip_cooperative_groups.h>
#include <cstdio>
#include <cstdint>
#include <cmath>
namespace cg = cooperative_groups;

#define LAS __attribute__((address_space(3)))
typedef unsigned short bf16_t;
typedef short bf16x8 __attribute__((ext_vector_type(8)));
typedef short s16x4 __attribute__((ext_vector_type(4)));
typedef float f32x4 __attribute__((ext_vector_type(4)));
typedef float f32x16 __attribute__((ext_vector_type(16)));
typedef unsigned u32x4 __attribute__((ext_vector_type(4)));
typedef unsigned u32x2 __attribute__((ext_vector_type(2)));

constexpr int SEQ = 4096, DM = 1024, NB = 8, MTOT = NB * SEQ, FF = 2816, NUP = 2 * FF, DEPTH = 4;
constexpr int MC = 16384;
constexpr float EPS = 1e-6f;
constexpr float LOG2E = 1.4426950408889634f;
constexpr int NTHREADS = 512, NWAVES = 8;
constexpr int LDS_BYTES = 147456;

constexpr size_t MiB = 1u << 20;
constexpr size_t WS_MOD = 0;
constexpr size_t WS_KVMOD = 4 * 8 * 6144 * 4;
constexpr size_t WS_BAR = 896 * 1024;
constexpr size_t WA_WIN = 1 * MiB;
constexpr size_t WA_WGRP = 5 * MiB;
constexpr size_t WA_WOUT = 6 * MiB;
constexpr size_t WA_WUP = 10 * MiB;
constexpr size_t WA_WDN = 32 * MiB;
constexpr size_t WA_H = 44 * MiB;
constexpr size_t WA_AV = 108 * MiB;
constexpr size_t WA_U = 108 * MiB, WA_PB = 172 * MiB, WA_Y = 236 * MiB;
constexpr size_t WB_WKV = 1 * MiB;
constexpr size_t WB_WQ = 13 * MiB;
constexpr size_t WB_WO = 25 * MiB;
constexpr size_t WB_WUP = 29 * MiB;
constexpr size_t WB_WDN = 51 * MiB;
constexpr size_t WB_H = 62 * MiB;
constexpr size_t WB_LSE = 94 * MiB;
constexpr size_t WB_KV = 97 * MiB;
constexpr size_t WB_Q = 289 * MiB;
constexpr size_t WB_AV = 289 * MiB;
constexpr size_t WB_H2 = 480 * MiB;
constexpr size_t WS_XTAIL = 128 * MiB;
constexpr size_t WS_HALO = 470 * MiB;
constexpr size_t WS_RAW0 = 474 * MiB;

__device__ __forceinline__ unsigned f2bf(float f) { unsigned u = __builtin_bit_cast(unsigned, f); return (u + 0x7fffu + ((u >> 16) & 1u)) >> 16; }
__device__ __forceinline__ unsigned cvt_pk_bf16(float lo, float hi) { unsigned r; asm volatile("v_cvt_pk_bf16_f32 %0, %1, %2" : "=v"(r) : "v"(lo), "v"(hi)); return r; }
__device__ __forceinline__ unsigned pk2(float lo, float hi) { unsigned r; asm("v_cvt_pk_bf16_f32 %0, %1, %2" : "=v"(r) : "v"(lo), "v"(hi)); return r; }
__device__ __forceinline__ float bflo(unsigned w) { return __builtin_bit_cast(float, w << 16); }
__device__ __forceinline__ float bfhi(unsigned w) { return __builtin_bit_cast(float, w & 0xffff0000u); }
__device__ __forceinline__ float wave_sum(float v) {
#pragma unroll
    for (int o = 1; o < 64; o <<= 1) v += __shfl_xor(v, o);
    return v;
}
#define LDS_WAIT() asm volatile("s_waitcnt lgkmcnt(0)" ::: "memory")

namespace pg8 {
constexpr int BM = 256, BK = 64, HALF = 128, HTB = HALF * BK * 2, STAGE_BYTES = 8 * HTB, NXCD = 8, WGM = 8;
__host__ __device__ __forceinline__ int lds_byte(int r, int c) { const int st = (r >> 4) * 2 + (c >> 5), rr = r & 15, cc = c & 31, ob = rr * 64 + cc * 2; return st * 1024 + (ob ^ (((ob >> 9) & 1) << 5)); }
__host__ __device__ __forceinline__ void stage_rc(int b, int& R, int& C) { const int st = b / 1024, sb = b % 1024, swz = sb ^ (((sb >> 9) & 1) << 5); R = (st >> 1) * 16 + swz / 64; C = (st & 1) * 32 + (swz % 64) / 2; }
__host__ __device__ __forceinline__ int perm32(int rho) { const int n = rho >> 4, i = rho & 15; return 8 * (i >> 2) + 4 * n + (i & 3); }

struct Unit { int pm, pn; };
struct Gemm { const bf16_t* A; const bf16_t* Bt; int M, N, K, lda, ldb, a_pn_koff; };

struct StaticOrder {
    int nM, nN, nwg, G, c;
    __device__ void init(int M, int N, int G_, int c_) { nM = M / BM; nN = N / BM; nwg = nM * nN; G = G_; c = c_; }
    __device__ bool next(int i, Unit& u) const {
        const long L = (long)i * G + c; if (L >= nwg) return false;
        int wgid = (int)L; { const int q = nwg / NXCD, r = nwg % NXCD, xcd = wgid % NXCD, off = wgid / NXCD; wgid = (xcd < r ? xcd * (q + 1) : r * (q + 1) + (xcd - r) * q) + off; }
        const int nig = WGM * nN, gid = wgid / nig, fm = gid * WGM, gsz = (nM - fm) < WGM ? (nM - fm) : WGM;
        u.pm = fm + ((wgid % nig) % gsz); u.pn = (wgid % nig) / gsz; return true;
    }
};

struct EpiBf16 {
    static constexpr bool PERM = true;
    bf16_t* O; int ldc; const float* cscale;
    __device__ __forceinline__ void operator()(const f32x4 (&acc)[2][2][4][2], const Unit& u, int wr, int wc, int fr, int fq) const {
        const int row0 = u.pm * BM + wr * 64 + fr; const int col0 = u.pn * BM + wc * 32 + 8 * fq;
        f32x4 sv[2][2];
#pragma unroll
        for (int bj = 0; bj < 2; ++bj)
#pragma unroll
            for (int n = 0; n < 2; ++n) sv[bj][n] = cscale ? *(const f32x4*)(cscale + col0 + bj * HALF + 4 * n) : (f32x4){1.f, 1.f, 1.f, 1.f};
#pragma unroll
        for (int ai = 0; ai < 2; ++ai)
#pragma unroll
            for (int m = 0; m < 4; ++m) { bf16_t* rowp = O + (size_t)(row0 + ai * HALF + m * 16) * ldc + col0;
#pragma unroll
                for (int bj = 0; bj < 2; ++bj) { const f32x4 v0 = acc[ai][bj][m][0] * sv[bj][0], v1 = acc[ai][bj][m][1] * sv[bj][1];
                    u32x4 w; w.x = cvt_pk_bf16(v0[0], v0[1]); w.y = cvt_pk_bf16(v0[2], v0[3]); w.z = cvt_pk_bf16(v1[0], v1[1]); w.w = cvt_pk_bf16(v1[2], v1[3]);
                    *(u32x4*)(rowp + bj * HALF) = w; } }
    }
};
struct EpiPoolU {
    static constexpr bool PERM = true;
    bf16_t* U; bf16_t* PB;
    __device__ __forceinline__ void operator()(const f32x4 (&acc)[2][2][4][2], const Unit& u, int wr, int wc, int fr, int fq) const {
        const int row0 = u.pm * BM + wr * 64 + fr; const int col0 = u.pn * BM + wc * 32 + 8 * fq;
#pragma unroll
        for (int ai = 0; ai < 2; ++ai)
#pragma unroll
            for (int m = 0; m < 4; ++m) { bf16_t* rowp = U + (size_t)(row0 + ai * HALF + m * 16) * DM + col0;
#pragma unroll
                for (int bj = 0; bj < 2; ++bj) { const f32x4 v0 = acc[ai][bj][m][0], v1 = acc[ai][bj][m][1];
                    u32x4 w; w.x = cvt_pk_bf16(v0[0], v0[1]); w.y = cvt_pk_bf16(v0[2], v0[3]); w.z = cvt_pk_bf16(v1[0], v1[1]); w.w = cvt_pk_bf16(v1[2], v1[3]);
                    *(u32x4*)(rowp + bj * HALF) = w; } }
        asm volatile("s_waitcnt vmcnt(0)" ::: "memory"); __builtin_amdgcn_s_barrier(); asm volatile("" ::: "memory");
        const int tid = ((wr * 4 + wc) * 64) + fq * 16 + fr, ch = tid & 31, seg = tid >> 5;
        if (seg >= 1) {
            const int w = 2 << u.pn, col = u.pn * BM + ch * 8; const size_t t0 = (size_t)u.pm * BM + seg * 16;
            const float inv = 1.f / (float)w;
            float sum[8];
#pragma unroll
            for (int e = 0; e < 8; ++e) sum[e] = 0.f;
            for (int j = 1; j <= w; ++j) { const u32x4 x = *(const u32x4*)(U + (t0 - j) * DM + col);
                sum[0] += bflo(x.x); sum[1] += bfhi(x.x); sum[2] += bflo(x.y); sum[3] += bfhi(x.y); sum[4] += bflo(x.z); sum[5] += bfhi(x.z); sum[6] += bflo(x.w); sum[7] += bfhi(x.w); }
#pragma unroll
            for (int hb = 0; hb < 2; ++hb) {
                u32x4 xs[8], ys[8];
#pragma unroll
                for (int k = 0; k < 8; ++k) { const size_t t = t0 + hb * 8 + k; xs[k] = *(const u32x4*)(U + t * DM + col); ys[k] = *(const u32x4*)(U + (t - w) * DM + col); }
#pragma unroll
                for (int k = 0; k < 8; ++k) { const size_t t = t0 + hb * 8 + k; const u32x4 x = xs[k], y = ys[k];
                    const float ut[8] = {bflo(x.x), bfhi(x.x), bflo(x.y), bfhi(x.y), bflo(x.z), bfhi(x.z), bflo(x.w), bfhi(x.w)};
                    const float ul[8] = {bflo(y.x), bfhi(y.x), bflo(y.y), bfhi(y.y), bflo(y.z), bfhi(y.z), bflo(y.w), bfhi(y.w)};
                    float o[8];
#pragma unroll
                    for (int e = 0; e < 8; ++e) { sum[e] += ut[e] - ul[e]; o[e] = sum[e] * inv - ut[e]; }
                    u32x4 wv; wv.x = cvt_pk_bf16(o[0], o[1]); wv.y = cvt_pk_bf16(o[2], o[3]); wv.z = cvt_pk_bf16(o[4], o[5]); wv.w = cvt_pk_bf16(o[6], o[7]);
                    *(u32x4*)(PB + t * DM + col) = wv; }
            }
        }
    }
};
struct EpiQKV {
    static constexpr bool PERM = true;
    bf16_t* O; size_t mat_stride; float scale;
    __device__ __forceinline__ void operator()(const f32x4 (&acc)[2][2][4][2], const Unit& u, int wr, int wc, int fr, int fq) const {
        const int colt = u.pn * BM; const int t = colt >> 10; const int g = t % 3; const int sh = 2 * g; const int dm1 = (1 << sh) - 1;
        const int hd0 = ((colt & 1023) >> 6) + (wc >> 1);
        bf16_t* base = O + (size_t)t * mat_stride + (size_t)hd0 * MC * 64 + (wc & 1) * 32 + 8 * fq;
        const int row0 = u.pm * BM + wr * 64 + fr;
#pragma unroll
        for (int ai = 0; ai < 2; ++ai)
#pragma unroll
            for (int m = 0; m < 4; ++m) { const int r = row0 + ai * HALF + m * 16; const int tt = r & 4095;
                const int dest = (r & ~4095) + ((tt & dm1) << (12 - sh)) + (tt >> sh);
                bf16_t* rowp = base + (size_t)dest * 64;
#pragma unroll
                for (int bj = 0; bj < 2; ++bj) { const f32x4 v0 = acc[ai][bj][m][0] * scale, v1 = acc[ai][bj][m][1] * scale;
                    u32x4 w; w.x = cvt_pk_bf16(v0[0], v0[1]); w.y = cvt_pk_bf16(v0[2], v0[3]); w.z = cvt_pk_bf16(v1[0], v1[1]); w.w = cvt_pk_bf16(v1[2], v1[3]);
                    *(u32x4*)(rowp + (size_t)bj * 2 * MC * 64) = w; } }
    }
};
template <bool BASE_F32>
struct EpiResid {
    static constexpr bool PERM = true;
    const float* base32; const bf16_t* base16; bf16_t* out; const float* gate; int row_base;
    __device__ __forceinline__ void operator()(const f32x4 (&acc)[2][2][4][2], const Unit& u, int wr, int wc, int fr, int fq) const {
        const int rowt = row_base + u.pm * BM; const int b = rowt >> 12;
        const int col0 = u.pn * BM + wc * 32 + 8 * fq; const int row0 = rowt + wr * 64 + fr;
        f32x4 gv[2][2];
#pragma unroll
        for (int bj = 0; bj < 2; ++bj)
#pragma unroll
            for (int n = 0; n < 2; ++n) gv[bj][n] = *(const f32x4*)(gate + (size_t)b * 6144 + col0 + bj * HALF + 4 * n);
        constexpr int NG = BASE_F32 ? 2 : 4;
#pragma unroll
        for (int rd = 0; rd < 8 / NG; ++rd) {
            u32x4 bw[NG][2]; f32x4 bf[BASE_F32 ? NG : 1][2][2];
#pragma unroll
            for (int mi = 0; mi < NG; ++mi) { const int gi = rd * NG + mi, ai = gi >> 2, m = gi & 3; const size_t off = (size_t)(row0 + ai * HALF + m * 16) * DM + col0;
#pragma unroll
                for (int bj = 0; bj < 2; ++bj) {
                    if (BASE_F32) { bf[BASE_F32 ? mi : 0][bj][0] = *(const f32x4*)(base32 + off + bj * HALF); bf[BASE_F32 ? mi : 0][bj][1] = *(const f32x4*)(base32 + off + bj * HALF + 4); }
                    else bw[mi][bj] = *(const u32x4*)(base16 + off + bj * HALF); } }
            asm volatile("" ::: "memory");
#pragma unroll
            for (int mi = 0; mi < NG; ++mi) { const int gi = rd * NG + mi, ai = gi >> 2, m = gi & 3; const size_t off = (size_t)(row0 + ai * HALF + m * 16) * DM + col0;
#pragma unroll
                for (int bj = 0; bj < 2; ++bj) {
                    f32x4 b0, b1;
                    if (BASE_F32) { b0 = bf[BASE_F32 ? mi : 0][bj][0]; b1 = bf[BASE_F32 ? mi : 0][bj][1]; }
                    else { const u32x4 w = bw[mi][bj]; b0 = (f32x4){bflo(w.x), bfhi(w.x), bflo(w.y), bfhi(w.y)}; b1 = (f32x4){bflo(w.z), bfhi(w.z), bflo(w.w), bfhi(w.w)}; }
                    const f32x4 v0 = b0 + gv[bj][0] * acc[ai][bj][m][0], v1 = b1 + gv[bj][1] * acc[ai][bj][m][1];
                    u32x4 w; w.x = cvt_pk_bf16(v0[0], v0[1]); w.y = cvt_pk_bf16(v0[2], v0[3]); w.z = cvt_pk_bf16(v1[0], v1[1]); w.w = cvt_pk_bf16(v1[2], v1[3]);
                    *(u32x4*)(out + off + bj * HALF) = w; } }
            asm volatile("" ::: "memory");
        }
    }
};

struct EpiConvGate {
    static constexpr bool PERM = true;
    bf16_t* G; const float* cw; const float* cb; float* halo; float* raw0; LAS float* xch;
    __device__ __forceinline__ void operator()(const f32x4 (&acc)[2][2][4][2], const Unit& u, int wr, int wc, int fr, int fq) const {
        const int lane = threadIdx.x & 63;
        const int colh = u.pn * 128 + wc * 32 + 8 * fq;
#define EA(ai, m, e) acc[ai][0][m][(e) >> 2][(e) & 3]
#define EV(ai, m, e) acc[ai][1][m][(e) >> 2][(e) & 3]
        if (fr >= 14) {
#pragma unroll
            for (int ai = 0; ai < 2; ++ai) { LAS float* xp = xch + ((((ai * 2 + wr) * 4 + wc) * 2 + (fr - 14)) * 4 + fq) * 8;
                *(LAS f32x4*)xp = acc[ai][0][3][0]; *(LAS f32x4*)(xp + 4) = acc[ai][0][3][1]; }
            if (wr == 1) { float* hp = halo + ((size_t)u.pm * 2 + (fr - 14)) * FF + colh; *(f32x4*)hp = acc[1][0][3][0]; *(f32x4*)(hp + 4) = acc[1][0][3][1]; }
        }
        asm volatile("s_waitcnt lgkmcnt(0)" ::: "memory"); __builtin_amdgcn_s_barrier(); asm volatile("" ::: "memory");
        f32x4 w0[2], w1[2], w2[2], bb[2];
#pragma unroll
        for (int nh = 0; nh < 2; ++nh) { const int colq = colh + 4 * nh; w0[nh] = *(const f32x4*)(cw + colq); w1[nh] = *(const f32x4*)(cw + FF + colq); w2[nh] = *(const f32x4*)(cw + 2 * FF + colq); bb[nh] = *(const f32x4*)(cb + colq); }
#pragma unroll
        for (int ai = 0; ai < 2; ++ai) {
            f32x4 q1[2], q2[2];
            const bool seam = (ai == 0 && wr == 0);
            if (!seam) { const int pai = wr == 1 ? ai : 0, pwr = wr == 1 ? 0 : 1; const LAS float* xp = xch + ((((pai * 2 + pwr) * 4 + wc) * 2) * 4 + fq) * 8;
#pragma unroll
                for (int nh = 0; nh < 2; ++nh) { const f32x4 p14 = *(const LAS f32x4*)(xp + 4 * nh), p15 = *(const LAS f32x4*)(xp + 32 + 4 * nh); q1[nh] = p15; q2[nh] = (fr == 1) ? p15 : p14; } }
            else { q1[0] = (f32x4){0.f, 0.f, 0.f, 0.f}; q1[1] = q1[0]; q2[0] = q1[0]; q2[1] = q1[0]; }
#pragma unroll
            for (int m = 0; m < 4; ++m) {
                u32x4 wout;
#pragma unroll
                for (int nh = 0; nh < 2; ++nh) {
                    const f32x4 av = acc[ai][0][m][nh], vv = acc[ai][1][m][nh];
                    f32x4 o;
#pragma unroll
                    for (int e = 0; e < 4; ++e) {
                        const float ac = av[e];
                        const float c1 = __builtin_bit_cast(float, __builtin_amdgcn_mov_dpp(__builtin_bit_cast(int, ac), 0x121, 0xF, 0xF, true));
                        const float c2 = __builtin_bit_cast(float, __builtin_amdgcn_mov_dpp(__builtin_bit_cast(int, ac), 0x122, 0xF, 0xF, true));
                        const float pr1 = fr >= 1 ? c1 : q1[nh][e];
                        const float pr2 = fr >= 2 ? c2 : q2[nh][e];
                        const float y = __builtin_fmaf(w2[nh][e], ac, __builtin_fmaf(w1[nh][e], pr1, __builtin_fmaf(w0[nh][e], pr2, bb[nh][e])));
                        o[e] = y * __builtin_amdgcn_rcpf(1.f + __builtin_amdgcn_exp2f(-LOG2E * y)) * vv[e];
                        q1[nh][e] = c1; q2[nh][e] = c2;
                    }
                    if (nh == 0) { wout.x = cvt_pk_bf16(o[0], o[1]); wout.y = cvt_pk_bf16(o[2], o[3]); } else { wout.z = cvt_pk_bf16(o[0], o[1]); wout.w = cvt_pk_bf16(o[2], o[3]); }
                }
                const int trow = ai * HALF + wr * 64 + m * 16 + fr;
                if (seam && m == 0 && fr < 2) {
                    float* rp = raw0 + ((size_t)u.pm * 2 + fr) * NUP + colh;
                    *(f32x4*)rp = acc[0][0][0][0]; *(f32x4*)(rp + 4) = acc[0][0][0][1]; *(f32x4*)(rp + FF) = acc[0][1][0][0]; *(f32x4*)(rp + FF + 4) = acc[0][1][0][1];
                } else *(u32x4*)(G + (size_t)(u.pm * BM + trow) * FF + colh) = wout;
            }
        }
#undef EA
#undef EV
    }
};

template <class Epi, class Sched>
__device__ __forceinline__ void gemm_phase(LAS unsigned char* lds, const Gemm g, const Sched& S, const Epi& E) {
    int tid_ = threadIdx.x; asm volatile("" : "+v"(tid_));
    const int tid = tid_, wid = __builtin_amdgcn_readfirstlane(tid >> 6), lane = tid & 63, wr = wid >> 2, wc = wid & 3, fr = lane & 15, fq = lane >> 4;
    const int K = g.K, nt = K / BK;
    unsigned voffA[2], voffB[2];
#pragma unroll
    for (int i = 0; i < 2; ++i) { int R, C; stage_rc(tid * 16 + i * 8192, R, C); const int Rb = Epi::PERM ? ((R & ~31) + perm32(R & 31)) : R;
        voffA[i] = (unsigned)(R * g.lda + C) * 2u; voffB[i] = (unsigned)(Rb * g.ldb + C) * 2u; }
    const size_t kstep = (size_t)(BK * 2);
    const size_t hstepA = (size_t)HALF * g.lda * 2, hstepB = (size_t)HALF * g.ldb * 2;
    const size_t tstepA = 2 * hstepA, tstepB = 2 * hstepB;
    const unsigned ldsw = (unsigned)wid * 1024u;
    const int aoff = lds_byte(wr * 64 + fr, fq * 8), boff = lds_byte(wc * 32 + fr, fq * 8);
#define PG8_SA(b, h) (((b) * 2 + (h)) * HTB)
#define PG8_SB(b, h) ((4 + (b) * 2 + (h)) * HTB)
#define PG8_STAGE(bufoff, gbase, voff) do { _Pragma("unroll") for (int _i = 0; _i < 2; ++_i) \
        __builtin_amdgcn_global_load_lds((const unsigned*)((const char*)(gbase) + (voff)[_i]), (LAS unsigned*)(lds + (bufoff) + ldsw + _i * 8192), 16, 0, 0); } while (0)
#define PG8_LDA(dst, b, h) do { _Pragma("unroll") for (int m = 0; m < 4; ++m) _Pragma("unroll") for (int k = 0; k < 2; ++k) dst[m][k] = *(const LAS bf16x8*)(lds + PG8_SA(b, h) + aoff + m * 2048 + k * 1024); } while (0)
#define PG8_LDB(dst, b, h) do { _Pragma("unroll") for (int n = 0; n < 2; ++n) _Pragma("unroll") for (int k = 0; k < 2; ++k) dst[n][k] = *(const LAS bf16x8*)(lds + PG8_SB(b, h) + boff + n * 2048 + k * 1024); } while (0)
#define PG8_MMA(ai, bj, At, Bt) do { __builtin_amdgcn_s_setprio(3); _Pragma("unroll") for (int m = 0; m < 4; ++m) _Pragma("unroll") for (int n = 0; n < 2; ++n) _Pragma("unroll") for (int k = 0; k < 2; ++k) \
        acc[ai][bj][m][n] = __builtin_amdgcn_mfma_f32_16x16x32_bf16(Bt[n][k], At[m][k], acc[ai][bj][m][n], 0, 0, 0); __builtin_amdgcn_s_setprio(0); } while (0)
#define PG8_WAIT_V(n) asm volatile("s_waitcnt vmcnt(" #n ")" ::: "memory")
#define PG8_WAIT_L(n) asm volatile("s_waitcnt lgkmcnt(" #n ")" ::: "memory")
#define PG8_BAR __builtin_amdgcn_s_barrier()
#define PG8_SCHED __builtin_amdgcn_sched_barrier(0)
#define PG8_BASEA(un) ((const char*)g.A + (size_t)(un).pm * tstepA + (size_t)(un).pn * (size_t)g.a_pn_koff * 2)
#define PG8_BASEB(un) ((const char*)g.Bt + (size_t)(un).pn * tstepB)
    Unit cur, nxt; int ui = 0;
    if (!S.next(0, cur)) return;
    f32x4 acc[2][2][4][2];
#pragma unroll
    for (int a = 0; a < 2; ++a)
#pragma unroll
        for (int b = 0; b < 2; ++b)
#pragma unroll
            for (int m = 0; m < 4; ++m)
#pragma unroll
                for (int n = 0; n < 2; ++n) acc[a][b][m][n] = (f32x4){0.f, 0.f, 0.f, 0.f};
    bf16x8 At[4][2], B0[2][2], B1[2][2];
    const char* cA = PG8_BASEA(cur); const char* cB = PG8_BASEB(cur);
    PG8_STAGE(PG8_SB(0, 0), cB, voffB); PG8_STAGE(PG8_SB(0, 1), cB + hstepB, voffB); PG8_STAGE(PG8_SA(0, 0), cA, voffA); PG8_STAGE(PG8_SA(0, 1), cA + hstepA, voffA);
    if (wr == 1) PG8_BAR;
    PG8_WAIT_V(2); PG8_BAR;
    PG8_STAGE(PG8_SB(1, 0), cB + kstep, voffB); PG8_STAGE(PG8_SA(1, 0), cA + kstep, voffA); PG8_STAGE(PG8_SB(1, 1), cB + hstepB + kstep, voffB);
    PG8_WAIT_V(6); PG8_BAR;
    for (;;) {
        const bool has_next = S.next(ui + 1, nxt);
        const char* nA = has_next ? PG8_BASEA(nxt) : cA; const char* nB = has_next ? PG8_BASEB(nxt) : cB;
        for (int t = 0; t < nt; t += 2) {
            const bool last = (t == nt - 2);
            const char* a1 = cA + (size_t)(t + 1) * kstep;
            const char* a2 = last ? nA : cA + (size_t)(t + 2) * kstep; const char* b2 = last ? nB : cB + (size_t)(t + 2) * kstep;
            const char* a3 = a2 + kstep; const char* b3 = b2 + kstep;
            PG8_LDB(B0, 0, 0); PG8_LDB(B1, 0, 1); PG8_SCHED; PG8_LDA(At, 0, 0); PG8_STAGE(PG8_SA(1, 1), a1 + hstepA, voffA);
            PG8_WAIT_V(8); PG8_WAIT_L(0); PG8_BAR; PG8_MMA(0, 0, At, B0); PG8_MMA(0, 1, At, B1); PG8_BAR; PG8_SCHED;
            PG8_LDA(At, 0, 1); PG8_STAGE(PG8_SB(0, 0), b2, voffB); PG8_STAGE(PG8_SB(0, 1), b2 + hstepB, voffB); PG8_STAGE(PG8_SA(0, 0), a2, voffA);
            PG8_WAIT_V(8); PG8_WAIT_L(0); PG8_BAR; PG8_MMA(1, 0, At, B0); PG8_MMA(1, 1, At, B1); PG8_BAR; PG8_SCHED;
            PG8_LDB(B0, 1, 0); PG8_LDB(B1, 1, 1); PG8_SCHED; PG8_LDA(At, 1, 0); PG8_STAGE(PG8_SA(0, 1), a2 + hstepA, voffA);
            PG8_WAIT_V(8); PG8_WAIT_L(0); PG8_BAR; PG8_MMA(0, 0, At, B0); PG8_MMA(0, 1, At, B1); PG8_BAR; PG8_SCHED;
            PG8_LDA(At, 1, 1); PG8_STAGE(PG8_SB(1, 0), b3, voffB); PG8_STAGE(PG8_SB(1, 1), b3 + hstepB, voffB); PG8_STAGE(PG8_SA(1, 0), a3, voffA);
            PG8_WAIT_V(8); PG8_WAIT_L(0); PG8_BAR; PG8_MMA(1, 0, At, B0); PG8_MMA(1, 1, At, B1); PG8_BAR; PG8_SCHED;
        }
        if (wr == 0) PG8_BAR;
        E(acc, cur, wr, wc, fr, fq);
        if (!has_next) break;
#pragma unroll
        for (int a = 0; a < 2; ++a)
#pragma unroll
            for (int b = 0; b < 2; ++b)
#pragma unroll
                for (int m = 0; m < 4; ++m)
#pragma unroll
                    for (int n = 0; n < 2; ++n) acc[a][b][m][n] = (f32x4){0.f, 0.f, 0.f, 0.f};
        cur = nxt; cA = nA; cB = nB; ++ui;
        if (wr == 1) PG8_BAR;
    }
    PG8_WAIT_V(0);
    PG8_BAR;
#undef PG8_SA
#undef PG8_SB
#undef PG8_STAGE
#undef PG8_LDA
#undef PG8_LDB
#undef PG8_MMA
#undef PG8_WAIT_V
#undef PG8_WAIT_L
#undef PG8_BAR
#undef PG8_SCHED
#undef PG8_BASEA
#undef PG8_BASEB
}
}

struct Ctx { LAS unsigned char* lds; int tid, lane, wave, bid, G; };
__device__ __forceinline__ Ctx relaunder(const Ctx& F0) { Ctx F = F0; int t = threadIdx.x; asm volatile("" : "+v"(t)); F.tid = t; F.lane = t & 63; F.wave = __builtin_amdgcn_readfirstlane(t >> 6); return F; }

template <bool AVPERM>
__device__ __forceinline__ void transpose_item(const float* W, int K, int N, bf16_t* WT, int row_off, LAS float* scr, int item, int lane) {
    const int nblk = N / 32, kb = item / nblk, nb = item % nblk, k0 = 64 * kb, n0 = 32 * nb;
    const int d0 = AVPERM ? (n0 < FF ? (n0 >> 7) * 256 + (n0 & 127) : ((n0 - FF) >> 7) * 256 + 128 + ((n0 - FF) & 127)) : n0;
    float wv[32];
#pragma unroll
    for (int i = 0; i < 32; ++i) { const int kk = 2 * i + (lane >> 5); wv[i] = W[(size_t)(k0 + kk) * N + n0 + (lane & 31)]; }
#pragma unroll
    for (int i = 0; i < 32; ++i) { const int kk = 2 * i + (lane >> 5); scr[kk * 33 + (lane & 31)] = wv[i]; }
    LDS_WAIT(); asm volatile("" ::: "memory");
    const int c = lane & 7;
#pragma unroll
    for (int j = 0; j < 4; ++j) { const int n = (lane >> 3) + 8 * j; const LAS float* s = scr + (8 * c) * 33 + n;
        u32x4 o; o.x = pk2(s[0 * 33], s[1 * 33]); o.y = pk2(s[2 * 33], s[3 * 33]); o.z = pk2(s[4 * 33], s[5 * 33]); o.w = pk2(s[6 * 33], s[7 * 33]);
        *(u32x4*)(WT + (size_t)(row_off + d0 + n) * K + k0 + 8 * c) = o; }
    LDS_WAIT(); asm volatile("" ::: "memory");
}
template <bool AVPERM = false>
__device__ __forceinline__ void transpose_matrix(const Ctx& F0, const float* W, int K, int N, bf16_t* WT, int row_off) {
    const Ctx F = relaunder(F0);
    LAS float* scr = (LAS float*)(F.lds + F.wave * 16384);
    const int gw = F.bid * NWAVES + F.wave, NGW = F.G * NWAVES, items = (K / 64) * (N / 32);
    for (int it = gw; it < items; it += NGW) transpose_item<AVPERM>(W, K, N, WT, row_off, scr, it, F.lane);
}

__device__ __forceinline__ void unpack8(const u32x4 w, float (&f)[8]) { f[0] = bflo(w.x); f[1] = bfhi(w.x); f[2] = bflo(w.y); f[3] = bfhi(w.y); f[4] = bflo(w.z); f[5] = bfhi(w.z); f[6] = bflo(w.w); f[7] = bfhi(w.w); }
__device__ __forceinline__ u32x4 pack8(const float (&f)[8]) { u32x4 w; w.x = pk2(f[0], f[1]); w.y = pk2(f[2], f[3]); w.z = pk2(f[4], f[5]); w.w = pk2(f[6], f[7]); return w; }

__device__ __forceinline__ void fold_pool_weights(const Ctx& F0, const float* wgrp, const float* pscale, const float* wout, bf16_t* WT) {
    const Ctx F = relaunder(F0);
    LAS float* WgS = (LAS float*)F.lds;
    LAS float* WoS = WgS + 4096;
    __syncthreads();
    for (int t = F.bid; t < 512; t += F.G) {
        const int L = t >> 8, kt = (t >> 4) & 15, nt = t & 15, k0 = kt * 64, n0 = nt * 64, g = k0 >> 8;
        const float* Wg = wgrp + (size_t)(L * 4 + g) * 65536 + (size_t)(k0 & 255) * 256;
        const float* Wo = wout + (size_t)L * DM * DM + (size_t)(g * 256) * DM + n0;
        const float* sc = pscale + L * DM + g * 256;
        const int n = F.tid & 63, kg = F.tid >> 6;
        float acc[8];
#pragma unroll
        for (int e = 0; e < 8; ++e) acc[e] = 0.f;
        for (int j0 = 0; j0 < 256; j0 += 64) {
#pragma unroll
            for (int i = 0; i < 8; ++i) { const int idx = F.tid + NTHREADS * i, r = idx >> 6, c = idx & 63;
                WgS[r * 64 + c] = Wg[(size_t)r * 256 + j0 + c];
                WoS[r * 64 + c] = Wo[(size_t)(j0 + r) * DM + c] * sc[j0 + r]; }
            __syncthreads();
#pragma unroll 8
            for (int j = 0; j < 64; ++j) { const float b = WoS[j * 64 + n];
#pragma unroll
                for (int e = 0; e < 8; ++e) acc[e] += WgS[(8 * kg + e) * 64 + j] * b; }
            __syncthreads();
        }
        *(u32x4*)(WT + (size_t)L * DM * DM + (size_t)(n0 + n) * DM + k0 + 8 * kg) = pack8(acc);
    }
}

__device__ __forceinline__ void mod_phase(const Ctx& F0, const float* c, const float* ada_w, const float* ada_b, const float* kv_ada_w, const float* kv_ada_b, float* mod, float* kvmod) {
    const Ctx F = relaunder(F0);
    LAS float* condT = (LAS float*)(F.lds + 131072 - 49152);
    LAS float* part = condT + 8192;
    __syncthreads();
    for (int i = F.tid; i < 8192; i += NTHREADS) { const int b = i >> 10, k = i & 1023; const float v = c[i]; condT[k * 8 + b] = v / (1.f + __expf(-v)); }
    __syncthreads();
    for (int it = F.bid; it < 416; it += F.G) {
        const float* W; const float* bias; float* outp; int N, cb;
        if (it < 384) { const int L = it / 96; cb = it % 96; W = ada_w + (size_t)L * 1024 * 6144; N = 6144; bias = ada_b + L * 6144; outp = mod + (size_t)L * 8 * 6144; }
        else { cb = it - 384; W = kv_ada_w; N = 2048; bias = kv_ada_b; outp = kvmod; }
        const int cl = F.tid & 63, kq = F.tid >> 6, col = cb * 64 + cl;
        float a0 = 0.f, a1 = 0.f, a2 = 0.f, a3 = 0.f, a4 = 0.f, a5 = 0.f, a6 = 0.f, a7 = 0.f;
#pragma unroll 16
        for (int k = kq * 128; k < kq * 128 + 128; ++k) {
            const float w = W[(size_t)k * N + col]; const f32x4 c0 = *(const LAS f32x4*)(condT + k * 8), c1 = *(const LAS f32x4*)(condT + k * 8 + 4);
            a0 += w * c0[0]; a1 += w * c0[1]; a2 += w * c0[2]; a3 += w * c0[3]; a4 += w * c1[0]; a5 += w * c1[1]; a6 += w * c1[2]; a7 += w * c1[3];
        }
        part[(kq * 8 + 0) * 64 + cl] = a0; part[(kq * 8 + 1) * 64 + cl] = a1; part[(kq * 8 + 2) * 64 + cl] = a2; part[(kq * 8 + 3) * 64 + cl] = a3;
        part[(kq * 8 + 4) * 64 + cl] = a4; part[(kq * 8 + 5) * 64 + cl] = a5; part[(kq * 8 + 6) * 64 + cl] = a6; part[(kq * 8 + 7) * 64 + cl] = a7;
        __syncthreads();
        { const int b = F.tid >> 6; float s = bias[cb * 64 + cl];
#pragma unroll
          for (int q = 0; q < 8; ++q) s += part[(q * 8 + b) * 64 + cl];
          outp[(size_t)b * N + cb * 64 + cl] = s; }
        __syncthreads();
    }
}

template <bool XBF16>
__device__ __forceinline__ void norm_phase(const Ctx& F0, const void* Xv, bf16_t* H, const float* g, const float* shift, const float* scale, int bstride, int row0, int nrows) {
    const Ctx F = relaunder(F0);
    const int gw = F.bid * NWAVES + F.wave, NGW = F.G * NWAVES;
    const int rpw = (nrows + NGW - 1) / NGW;
    int r = row0 + gw * rpw; const int rend = min(row0 + nrows, r + rpw);
    int curb = -1; f32x4 gs[4], shv[4];
    for (; r < rend; ++r) {
        const int b = r >> 12;
        if (b != curb) { curb = b;
#pragma unroll
            for (int j = 0; j < 4; ++j) { const int col = 4 * F.lane + 256 * j; const f32x4 gg = *(const f32x4*)(g + col), sc = *(const f32x4*)(scale + (size_t)b * bstride + col);
                gs[j] = gg * (sc + 1.f); shv[j] = *(const f32x4*)(shift + (size_t)b * bstride + col); } }
        f32x4 v[4]; float ss = 0.f;
        if (XBF16) { const u32x2* xr = (const u32x2*)((const bf16_t*)Xv + (size_t)r * DM) + F.lane;
#pragma unroll
            for (int j = 0; j < 4; ++j) { const u32x2 w = xr[64 * j]; v[j] = (f32x4){bflo(w.x), bfhi(w.x), bflo(w.y), bfhi(w.y)}; } }
        else { const f32x4* xr = (const f32x4*)((const float*)Xv + (size_t)r * DM) + F.lane;
#pragma unroll
            for (int j = 0; j < 4; ++j) v[j] = xr[64 * j]; }
#pragma unroll
        for (int j = 0; j < 4; ++j) ss += (v[j].x * v[j].x + v[j].y * v[j].y) + (v[j].z * v[j].z + v[j].w * v[j].w);
        const float rstd = 1.f / sqrtf(wave_sum(ss) * (1.f / DM) + EPS);
        u32x2* o8 = (u32x2*)(H + (size_t)(r - row0) * DM) + F.lane;
#pragma unroll
        for (int j = 0; j < 4; ++j) { const f32x4 y = v[j] * rstd * gs[j] + shv[j]; u32x2 w; w.x = pk2(y.x, y.y); w.y = pk2(y.z, y.w); o8[64 * j] = w; }
    }
}
__device__ __forceinline__ void final_norm_phase(const Ctx& F0, const bf16_t* Xs, int soff, float* out, const float* g, int r0, int r1) {
    const Ctx F = relaunder(F0);
    const int gw = F.bid * NWAVES + F.wave, NGW = F.G * NWAVES;
    f32x4 gs[4];
#pragma unroll
    for (int j = 0; j < 4; ++j) gs[j] = *(const f32x4*)(g + 4 * F.lane + 256 * j);
    for (int r = r0 + gw; r < r1; r += NGW) {
        const u32x2* xr = (const u32x2*)(Xs + (size_t)(r - soff) * DM) + F.lane;
        f32x4 v[4]; float ss = 0.f;
#pragma unroll
        for (int j = 0; j < 4; ++j) { const u32x2 w = xr[64 * j]; v[j] = (f32x4){bflo(w.x), bfhi(w.x), bflo(w.y), bfhi(w.y)}; ss += (v[j].x * v[j].x + v[j].y * v[j].y) + (v[j].z * v[j].z + v[j].w * v[j].w); }
        const float rstd = 1.f / sqrtf(wave_sum(ss) * (1.f / DM) + EPS);
        f32x4* orow = (f32x4*)(out + (size_t)r * DM) + F.lane;
#pragma unroll
        for (int j = 0; j < 4; ++j) orow[64 * j] = v[j] * rstd * gs[j];
    }
}
__device__ __forceinline__ void copy_rows_phase(const Ctx& F0, const bf16_t* src, bf16_t* dst, int nrows) {
    const Ctx F = relaunder(F0);
    const int gw = F.bid * NWAVES + F.wave, NGW = F.G * NWAVES;
    for (int r = gw; r < nrows; r += NGW) { const u32x4* s = (const u32x4*)(src + (size_t)r * DM) + F.lane; u32x4* d = (u32x4*)(dst + (size_t)r * DM) + F.lane; d[0] = s[0]; d[64] = s[64]; }
}
__device__ __forceinline__ void pool_phase(const Ctx& F0, const bf16_t* U, bf16_t* PB) {
    const Ctx F = relaunder(F0);
    const int nitems = (MTOT / 32) * 128;
    for (int it = F.bid * NTHREADS + F.tid; it < nitems; it += F.G * NTHREADS) {
        const int rb = it >> 7, ch = it & 127, t0 = rb * 32, col = ch * 8, w = 2 << (col >> 8), st0 = t0 & 4095;
        float sum[8];
#pragma unroll
        for (int e = 0; e < 8; ++e) sum[e] = 0.f;
        for (int j = 1; j <= w; ++j) if (st0 - j >= 0) { float f[8]; unpack8(*(const u32x4*)(U + (size_t)(t0 - j) * DM + col), f);
#pragma unroll
            for (int e = 0; e < 8; ++e) sum[e] += f[e]; }
        for (int i = 0; i < 32; ++i) {
            const int t = t0 + i, st = st0 + i; float ut[8]; unpack8(*(const u32x4*)(U + (size_t)t * DM + col), ut);
#pragma unroll
            for (int e = 0; e < 8; ++e) sum[e] += ut[e];
            if (st >= w) { float f[8]; unpack8(*(const u32x4*)(U + (size_t)(t - w) * DM + col), f);
#pragma unroll
                for (int e = 0; e < 8; ++e) sum[e] -= f[e]; }
            const float inv = 1.f / (float)min(st + 1, w); float o[8];
#pragma unroll
            for (int e = 0; e < 8; ++e) o[e] = sum[e] * inv - ut[e];
            *(u32x4*)(PB + (size_t)t * DM + col) = pack8(o);
        }
    }
}

template <class Sched>
__device__ __forceinline__ void pool_fix_units(const Ctx& F0, const Sched& S, const bf16_t* U, bf16_t* PB) {
    const Ctx F = relaunder(F0);
    pg8::Unit u;
    for (int i = 0; S.next(i, u); ++i) {
        const int ch = F.tid & 127, rq = F.tid >> 7, col = ch * 8, w = 2 << (col >> 8);
        const int t0 = u.pm * 256 + 4 * rq, st0 = t0 & 4095;
        float sum[8];
#pragma unroll
        for (int e = 0; e < 8; ++e) sum[e] = 0.f;
        for (int j = 1; j <= w; ++j) if (st0 - j >= 0) { float f[8]; unpack8(*(const u32x4*)(U + (size_t)(t0 - j) * DM + col), f);
#pragma unroll
            for (int e = 0; e < 8; ++e) sum[e] += f[e]; }
        for (int k = 0; k < 4; ++k) { const int t = t0 + k, st = st0 + k; float ut[8]; unpack8(*(const u32x4*)(U + (size_t)t * DM + col), ut);
#pragma unroll
            for (int e = 0; e < 8; ++e) sum[e] += ut[e];
            if (st >= w) { float f[8]; unpack8(*(const u32x4*)(U + (size_t)(t - w) * DM + col), f);
#pragma unroll
                for (int e = 0; e < 8; ++e) sum[e] -= f[e]; }
            const float inv = 1.f / (float)min(st + 1, w); float o[8];
#pragma unroll
            for (int e = 0; e < 8; ++e) o[e] = sum[e] * inv - ut[e];
            *(u32x4*)(PB + (size_t)t * DM + col) = pack8(o); }
    }
    asm volatile("s_waitcnt vmcnt(0)" ::: "memory");
    __syncthreads();
}

template <class Sched>
__device__ __forceinline__ void conv_fix_units(const Ctx& F0, const Sched& S, bf16_t* G, const float* cw, const float* cb, const float* halo, const float* raw0, int row0) {
    const Ctx F = relaunder(F0);
    pg8::Unit u;
    for (int i = 0; S.next(i, u); ++i) {
        const int tile = u.pm;
        if (F.tid < 352) {
            const int col = F.tid * 8;
            const bool seq0 = (((row0 + tile * 256) & 4095) == 0);
            float h254[8], h255[8];
#pragma unroll
            for (int e = 0; e < 8; ++e) { h254[e] = 0.f; h255[e] = 0.f; }
            if (!seq0) { const float* hp = halo + ((size_t)(tile - 1) * 2) * FF + col;
#pragma unroll
                for (int e = 0; e < 8; ++e) { h254[e] = hp[e]; h255[e] = hp[FF + e]; } }
            const float* rp = raw0 + ((size_t)tile * 2) * NUP + col;
            float o0[8], o1[8];
#pragma unroll
            for (int e = 0; e < 8; ++e) { const float a0 = rp[e], v0 = rp[FF + e], a1 = rp[NUP + e], v1 = rp[NUP + FF + e];
                const float w0 = cw[col + e], w1 = cw[FF + col + e], w2 = cw[2 * FF + col + e], bb = cb[col + e];
                const float y0 = bb + w0 * h254[e] + w1 * h255[e] + w2 * a0, y1 = bb + w0 * h255[e] + w1 * a0 + w2 * a1;
                o0[e] = y0 / (1.f + __expf(-y0)) * v0; o1[e] = y1 / (1.f + __expf(-y1)) * v1; }
            *(u32x4*)(G + (size_t)(tile * 256) * FF + col) = pack8(o0); *(u32x4*)(G + (size_t)(tile * 256 + 1) * FF + col) = pack8(o1);
        }
    }
    asm volatile("s_waitcnt vmcnt(0)" ::: "memory");
    __syncthreads();
}

__device__ __forceinline__ int crow(int r, int hi) { return (r & 3) + 8 * (r >> 2) + 4 * hi; }
__device__ __forceinline__ void attn_phase(const Ctx& F0, bf16_t* Qc, const bf16_t* KVc, float* LSE) {
    const Ctx F = relaunder(F0);
    LAS unsigned char* lds = F.lds;
    const int tid = F.tid, lane = F.lane, wid = F.wave, q = lane & 31, hi = lane >> 5;
    constexpr size_t MAT = (size_t)MC * 1024;
    constexpr int VOFF = 49152, NUNITS = 3072;
    const int q4 = (lane & 15) >> 2, p4 = lane & 3, dc16 = (lane >> 4) & 1;
    const int slot_l = tid >> 3, c_l = tid & 7;
    u32x4 kreg[6], vreg[6]; bf16x8 qn[4];
#define ATT_DECODE(u, h, rb, g, sh, prow0, has_prev) const int h = (u) & 15, rb = ((u) >> 4) & 63, g = (u) >> 10, sh = 2 * g, prow0 = rb * 256; const bool has_prev = ((prow0 & ((4096 >> sh) - 1)) != 0)
#define ATT_ISSUE(u) do { ATT_DECODE(u, h_, rb_, g_, sh_, prow0_, hp_); \
        const bf16_t* Kg_ = KVc + (size_t)g_ * MAT + (size_t)h_ * MC * 64 + c_l * 8; const bf16_t* Vg_ = KVc + (size_t)(3 + g_) * MAT + (size_t)h_ * MC * 64 + c_l * 8; \
        _Pragma("unroll") for (int i = 0; i < 6; ++i) if (hp_ || i >= 2) { const long prow = (long)prow0_ - 128 + slot_l + 64 * i; kreg[i] = *(const u32x4*)(Kg_ + prow * 64); vreg[i] = *(const u32x4*)(Vg_ + prow * 64); } \
        const bf16_t* Qw_ = Qc + (size_t)g_ * MAT + ((size_t)h_ * MC + prow0_ + 32 * wid + q) * 64; \
        _Pragma("unroll") for (int s = 0; s < 4; ++s) qn[s] = *(const bf16x8*)(Qw_ + 16 * s + 8 * hi); } while (0)
    int u = F.bid;
    if (u < NUNITS) ATT_ISSUE(u);
    while (u < NUNITS) {
        ATT_DECODE(u, h, rb, g, sh, prow0, has_prev);
        bf16_t* Qw = Qc + (size_t)g * MAT + ((size_t)h * MC + prow0 + 32 * wid + q) * 64;
        bf16x8 qf[4];
#pragma unroll
        for (int s = 0; s < 4; ++s) qf[s] = qn[s];
#pragma unroll
        for (int i = 0; i < 6; ++i) if (has_prev || i >= 2) { const int slot = slot_l + 64 * i;
            *(LAS u32x4*)(lds + slot * 128 + ((c_l ^ ((slot >> 1) & 7)) << 4)) = kreg[i];
            *(LAS u32x4*)(lds + VOFF + slot * 128 + ((c_l << 4) ^ (((slot >> 1) & 1) << 6))) = vreg[i]; }
        __syncthreads();
        const int un = u + F.G;
        if (un < NUNITS) ATT_ISSUE(un);
        const int ii = g * 16 + h; const float ee = ii < 32 ? 0.125f * (float)(ii + 1) : 4.0f + 0.25f * (float)(ii - 31);
        const float slope2 = exp2f(-ee) * (float)(1 << sh) * LOG2E;
        float mx = -INFINITY, lsum = 0.f;
        f32x16 o0 = {0.f, 0.f, 0.f, 0.f, 0.f, 0.f, 0.f, 0.f, 0.f, 0.f, 0.f, 0.f, 0.f, 0.f, 0.f, 0.f}, o1 = o0;
        f32x16 cf;
#pragma unroll
        for (int r = 0; r < 16; ++r) cf[r] = slope2 * (float)crow(r, hi);
        const int qq = q - 4 * hi;
        const int i0 = has_prev ? 0 : (wid < 4 ? 4 - wid : 0);
#define ATT_TILE(i, MASKLO, MASKHI) do { \
            const int sb = 32 * wid + 32 * (i); \
            const float base = -slope2 * (float)(q + 128 - 32 * (i)); \
            f32x16 a; \
            _Pragma("unroll") for (int r = 0; r < 16; ++r) a[r] = cf[r] + base; \
            { const int slot = sb + q; \
              _Pragma("unroll") for (int s = 0; s < 4; ++s) { const int c = 2 * s + hi; const bf16x8 kf = *(const LAS bf16x8*)(lds + slot * 128 + ((c ^ ((slot >> 1) & 7)) << 4)); \
                  a = __builtin_amdgcn_mfma_f32_32x32x16_bf16(kf, qf[s], a, 0, 0, 0); } } \
            if (MASKHI) { _Pragma("unroll") for (int r = 0; r < 16; ++r) if (crow(r, 0) > qq) a[r] = -INFINITY; }     \
            if (MASKLO) { _Pragma("unroll") for (int r = 0; r < 16; ++r) if (crow(r, 0) < qq) a[r] = -INFINITY; }     \
            float tmax = fmaxf(fmaxf(a[0], a[1]), fmaxf(a[2], a[3])); \
            _Pragma("unroll") for (int r = 4; r < 16; r += 4) tmax = fmaxf(tmax, fmaxf(fmaxf(a[r], a[r + 1]), fmaxf(a[r + 2], a[r + 3]))); \
            tmax = fmaxf(tmax, __shfl_xor(tmax, 32)); \
            if (__any(tmax > mx)) { const float mnew = fmaxf(mx, tmax); const float alpha = __builtin_amdgcn_exp2f(mx - mnew); mx = mnew; lsum *= alpha; \
                _Pragma("unroll") for (int r = 0; r < 16; ++r) { o0[r] *= alpha; o1[r] *= alpha; } } \
            float ps = 0.f; \
            _Pragma("unroll") for (int r = 0; r < 16; ++r) { const float p = __builtin_amdgcn_exp2f(a[r] - mx); a[r] = p; ps += p; } \
            lsum += ps; \
            _Pragma("unroll") for (int s2 = 0; s2 < 2; ++s2) { \
                u32x4 pw; pw.x = cvt_pk_bf16(a[8 * s2 + 0], a[8 * s2 + 1]); pw.y = cvt_pk_bf16(a[8 * s2 + 2], a[8 * s2 + 3]); \
                pw.z = cvt_pk_bf16(a[8 * s2 + 4], a[8 * s2 + 5]); pw.w = cvt_pk_bf16(a[8 * s2 + 6], a[8 * s2 + 7]); \
                const bf16x8 pf = __builtin_bit_cast(bf16x8, pw); \
                const int slotA = sb + 16 * s2 + 4 * hi + q4; \
                _Pragma("unroll") for (int dh = 0; dh < 2; ++dh) { \
                    const int colb = (32 * dh + 16 * dc16 + 4 * p4) * 2; \
                    const int addr = VOFF + slotA * 128 + (colb ^ (((slotA >> 1) & 1) << 6)); \
                    const s16x4 lo = __builtin_bit_cast(s16x4, __builtin_amdgcn_ds_read_tr16_b64_v4i16((LAS s16x4*)(lds + addr))); \
                    const s16x4 hh = __builtin_bit_cast(s16x4, __builtin_amdgcn_ds_read_tr16_b64_v4i16((LAS s16x4*)(lds + addr + 1024))); \
                    const bf16x8 vf = (bf16x8){lo[0], lo[1], lo[2], lo[3], hh[0], hh[1], hh[2], hh[3]}; \
                    if (dh == 0) o0 = __builtin_amdgcn_mfma_f32_32x32x16_bf16(vf, pf, o0, 0, 0, 0); \
                    else o1 = __builtin_amdgcn_mfma_f32_32x32x16_bf16(vf, pf, o1, 0, 0, 0); } } \
        } while (0)
        ATT_TILE(4, false, true);
        for (int i = 3; i >= 1 && i >= i0; --i) ATT_TILE(i, false, false);
        if (i0 == 0) ATT_TILE(0, true, false);
#undef ATT_TILE
        lsum += __shfl_xor(lsum, 32);
        const float inv = 1.f / lsum;
#pragma unroll
        for (int rq = 0; rq < 4; ++rq) {
            u32x2 w0; w0.x = cvt_pk_bf16(o0[4 * rq + 0] * inv, o0[4 * rq + 1] * inv); w0.y = cvt_pk_bf16(o0[4 * rq + 2] * inv, o0[4 * rq + 3] * inv);
            u32x2 w1; w1.x = cvt_pk_bf16(o1[4 * rq + 0] * inv, o1[4 * rq + 1] * inv); w1.y = cvt_pk_bf16(o1[4 * rq + 2] * inv, o1[4 * rq + 3] * inv);
            *(u32x2*)(Qw + 8 * rq + 4 * hi) = w0; *(u32x2*)(Qw + 32 + 8 * rq + 4 * hi) = w1;
        }
        if (hi == 0) LSE[((size_t)g * MC + prow0 + 32 * wid + q) * 16 + h] = mx + log2f(lsum);
        __syncthreads();
        u = un;
    }
#undef ATT_DECODE
#undef ATT_ISSUE
}
__device__ __forceinline__ void merge_phase(const Ctx& F0, const bf16_t* Oc, const float* LSE, bf16_t* OM) {
    const Ctx F = relaunder(F0);
    const int gw = F.bid * NWAVES + F.wave, NGW = F.G * NWAVES;
    constexpr size_t MAT = (size_t)MC * 1024;
    const int col = F.lane * 16, h = F.lane >> 2;
    for (int r = gw; r < MC; r += NGW) {
        const int tt = r & 4095, bb = r & ~4095;
        int pr[3]; float l[3];
#pragma unroll
        for (int g = 0; g < 3; ++g) { const int sh = 2 * g; pr[g] = bb + ((tt & ((1 << sh) - 1)) << (12 - sh)) + (tt >> sh); l[g] = LSE[((size_t)g * MC + pr[g]) * 16 + h]; }
        const float mx = fmaxf(l[0], fmaxf(l[1], l[2]));
        float w[3]; w[0] = exp2f(l[0] - mx); w[1] = exp2f(l[1] - mx); w[2] = exp2f(l[2] - mx);
        const float inv = 1.f / (w[0] + w[1] + w[2]);
        float acc[16];
#pragma unroll
        for (int e = 0; e < 16; ++e) acc[e] = 0.f;
#pragma unroll
        for (int g = 0; g < 3; ++g) { const bf16_t* p = Oc + (size_t)g * MAT + ((size_t)h * MC + pr[g]) * 64 + (F.lane & 3) * 16; float f0[8], f1[8]; unpack8(*(const u32x4*)p, f0); unpack8(*(const u32x4*)(p + 8), f1);
            const float wg = w[g] * inv;
#pragma unroll
            for (int e = 0; e < 8; ++e) { acc[e] += wg * f0[e]; acc[8 + e] += wg * f1[e]; } }
        float o0[8], o1[8];
#pragma unroll
        for (int e = 0; e < 8; ++e) { o0[e] = acc[e]; o1[e] = acc[8 + e]; }
        bf16_t* op = OM + (size_t)r * DM + col; *(u32x4*)op = pack8(o0); *(u32x4*)(op + 8) = pack8(o1);
    }
}

#define XB_TMO      128
#define XB_XCNT(j)  (256  + 64 * (j))
#define XB_XSUB(j)  (1280 + 64 * (j))
#define XB_XGEN(j)  (2304 + 64 * (j))
#define XB_TOP      3328
#define XB_TOPGEN   3392
#define XCD_BAR_WORDS 3456
#define XB_SPIN_CAP (1u << 18)
__device__ __forceinline__ unsigned xb_ld(unsigned* p)              { return __hip_atomic_load(p, __ATOMIC_RELAXED, __HIP_MEMORY_SCOPE_AGENT); }
__device__ __forceinline__ unsigned xb_add(unsigned* p, unsigned v) { return __hip_atomic_fetch_add(p, v, __ATOMIC_RELAXED, __HIP_MEMORY_SCOPE_AGENT); }
__device__ __forceinline__ unsigned xb_xcc_id() { return (unsigned)__builtin_amdgcn_s_getreg((3 << 11) | 20) & 0xFu; }
#define XB_SPIN(cond, bar) do { unsigned _sp = 0; while (cond) { __builtin_amdgcn_s_sleep(1); \
    if ((++_sp & 255u) == 0u) { if (xb_ld(&(bar)[XB_TMO])) break; if (_sp > XB_SPIN_CAP) { atomicAdd(&(bar)[XB_TMO], 1u); break; } } } } while (0)
struct XcdBarrier { unsigned* bar; unsigned x; volatile LAS unsigned* st; };
__device__ __forceinline__ XcdBarrier xcd_barrier_post(unsigned* bar, volatile LAS unsigned* st) {
    XcdBarrier b; b.bar = bar; b.x = xb_xcc_id(); b.st = st;
    if (threadIdx.x == 0) (void)xb_add(&bar[XB_XCNT(b.x)], 1u);
    return b;
}
__device__ __forceinline__ void xcd_barrier_complete(unsigned* bar, unsigned x, unsigned& nloc, unsigned& nx) {
    const unsigned G = gridDim.x * gridDim.y * gridDim.z;
    unsigned sum, cnt, mine, sp = 0u;
    for (;;) {
        sum = 0u; cnt = 0u; mine = 0u;
#pragma unroll
        for (unsigned j = 0; j < 16; ++j) { const unsigned c = xb_ld(&bar[XB_XCNT(j)]); sum += c; cnt += (c > 0u) ? 1u : 0u; mine = (j == x) ? c : mine; }
        if (sum == G) break;
        __builtin_amdgcn_s_sleep(1);
        if ((++sp & 255u) == 0u) { if (xb_ld(&bar[XB_TMO])) break; if (sp > XB_SPIN_CAP) { atomicAdd(&bar[XB_TMO], 1u); break; } }
    }
    nloc = mine > 0u ? mine : 1u; nx = cnt > 0u ? cnt : 1u;
}
__device__ __forceinline__ void xcd_barrier(const XcdBarrier& b) {
    asm volatile("s_waitcnt vmcnt(0)" ::: "memory");
    __syncthreads();
    int t0_ = threadIdx.x; asm volatile("" : "+v"(t0_));
    if (t0_ == 0) {
        unsigned* bar = b.bar; unsigned bx = b.x; asm volatile("" : "+s"(bx));
        __builtin_amdgcn_s_waitcnt(0);
        unsigned nloc = b.st[0], nx = b.st[1];
        if (nloc == 0u) { xcd_barrier_complete(bar, bx, nloc, nx); b.st[0] = nloc; b.st[1] = nx; }
        const unsigned old = xb_add(&bar[XB_XSUB(bx)], 1u);
        const unsigned gen = old / nloc;
        if (old + 1u == (gen + 1u) * nloc) {
            __builtin_amdgcn_fence(__ATOMIC_RELEASE, "agent");
            asm volatile("s_waitcnt vmcnt(0)" ::: "memory");
            const unsigned og = xb_add(&bar[XB_TOP], 1u);
            const unsigned tg = og / nx;
            if (og + 1u == (tg + 1u) * nx) xb_add(&bar[XB_TOPGEN], 1u);
            else XB_SPIN(xb_ld(&bar[XB_TOPGEN]) == tg, bar);
            __builtin_amdgcn_fence(__ATOMIC_ACQUIRE, "agent");
            xb_add(&bar[XB_XGEN(bx)], 1u);
            asm volatile("s_waitcnt vmcnt(0)" ::: "memory");
        } else {
            XB_SPIN(xb_ld(&bar[XB_XGEN(bx)]) == gen, bar);
            __builtin_amdgcn_fence(__ATOMIC_ACQUIRE, "agent");
            asm volatile("s_waitcnt vmcnt(0)" ::: "memory");
        }
    }
    __syncthreads();
}

struct Args { const float* in[21]; float* out; unsigned char* ws; };
enum { I_X = 0, I_C, I_ADAW, I_ADAB, I_N1G, I_N2G, I_PWIN, I_PWGRP, I_PSCALE, I_PWOUT, I_KVNG, I_KVADAW, I_KVADAB, I_WKV, I_WQ, I_WO, I_WUP, I_CONVW, I_CONVB, I_WDN, I_FING };

__global__ void __launch_bounds__(NTHREADS, 2) mega_fwd(Args a) {
    extern __shared__ __attribute__((aligned(16))) unsigned char lds_raw[];
    cg::grid_group grid = cg::this_grid();
    Ctx F; F.lds = (LAS unsigned char*)lds_raw; F.tid = threadIdx.x; F.lane = F.tid & 63; F.wave = __builtin_amdgcn_readfirstlane(F.tid >> 6); F.bid = blockIdx.x; F.G = gridDim.x;
    unsigned char* ws = a.ws;
    float* mod = (float*)(ws + WS_MOD); float* kvmod = (float*)(ws + WS_KVMOD);
    bf16_t* X = (bf16_t*)((unsigned char*)a.out + 64 * MiB);
    float* halo = (float*)(ws + WS_HALO); float* raw0 = (float*)(ws + WS_RAW0);
    LAS float* xch = (LAS float*)(F.lds + 131072 + 4096);
#define GSYNC_CG() do { asm volatile("s_waitcnt vmcnt(0)" ::: "memory"); grid.sync(); __builtin_amdgcn_fence(__ATOMIC_ACQUIRE, "agent"); } while (0)
#define GSYNC() xcd_barrier(bar)
    volatile LAS unsigned* MISC = (volatile LAS unsigned*)(F.lds + 131072 + 320);
    if (F.tid < 32) MISC[F.tid] = 0u;
    unsigned* barw = (unsigned*)(ws + WS_BAR);
    __syncthreads();

    for (int L = 0; L < 2; ++L) {
        transpose_matrix(F, a.in[I_PWIN] + (size_t)L * DM * DM, DM, DM, (bf16_t*)(ws + WA_WIN) + (size_t)L * DM * DM, 0);
        transpose_matrix<true>(F, a.in[I_WUP] + (size_t)L * DM * NUP, DM, NUP, (bf16_t*)(ws + WA_WUP) + (size_t)L * DM * NUP, 0);
        transpose_matrix(F, a.in[I_WDN] + (size_t)L * FF * DM, FF, DM, (bf16_t*)(ws + WA_WDN) + (size_t)L * FF * DM, 0);
    }
    fold_pool_weights(F, a.in[I_PWGRP], a.in[I_PSCALE], a.in[I_PWOUT], (bf16_t*)(ws + WA_WOUT));
    mod_phase(F, a.in[I_C], a.in[I_ADAW], a.in[I_ADAB], a.in[I_KVADAW], a.in[I_KVADAB], mod, kvmod);
    const XcdBarrier bar = xcd_barrier_post(barw, MISC + 8);
    if (a.ws == nullptr) GSYNC_CG();
    GSYNC();

    for (int L = 0; L < 2; ++L) {
        const float* modL = mod + (size_t)L * 8 * 6144;
        bf16_t* H = (bf16_t*)(ws + WA_H); bf16_t* U = (bf16_t*)(ws + WA_U); bf16_t* PB = (bf16_t*)(ws + WA_PB); bf16_t* AV = (bf16_t*)(ws + WA_AV);
        if (L == 0) norm_phase<false>(F, a.in[I_X], H, a.in[I_N1G] + L * DM, modL + 0, modL + 1024, 6144, 0, MTOT);
        else norm_phase<true>(F, X, H, a.in[I_N1G] + L * DM, modL + 0, modL + 1024, 6144, 0, MTOT);
        GSYNC();
        { pg8::Gemm g{H, (bf16_t*)(ws + WA_WIN) + (size_t)L * DM * DM, MTOT, DM, DM, DM, DM, 0}; pg8::StaticOrder S; S.init(MTOT, DM, F.G, F.bid);
          pg8::EpiPoolU E{U, PB}; pg8::gemm_phase(F.lds, g, S, E); }
        GSYNC();
        { pg8::Gemm g{PB, (bf16_t*)(ws + WA_WOUT) + (size_t)L * DM * DM, MTOT, DM, DM, DM, DM, 0}; pg8::StaticOrder S; S.init(MTOT, DM, F.G, F.bid);
          pool_fix_units(F, S, U, PB);
          if (L == 0) { pg8::EpiResid<true> E{a.in[I_X], nullptr, X, modL + 2048, 0}; pg8::gemm_phase(F.lds, g, S, E); }
          else { pg8::EpiResid<false> E{nullptr, X, X, modL + 2048, 0}; pg8::gemm_phase(F.lds, g, S, E); } }
        GSYNC();
        norm_phase<true>(F, X, H, a.in[I_N2G] + L * DM, modL + 3072, modL + 4096, 6144, 0, MTOT);
        GSYNC();
        { pg8::Gemm g{H, (bf16_t*)(ws + WA_WUP) + (size_t)L * DM * NUP, MTOT, NUP, DM, DM, DM, 0}; pg8::StaticOrder S; S.init(MTOT, NUP, F.G, F.bid);
          pg8::EpiConvGate E{AV, a.in[I_CONVW] + (size_t)L * 3 * FF, a.in[I_CONVB] + (size_t)L * FF, halo, raw0, xch}; pg8::gemm_phase(F.lds, g, S, E); }
        GSYNC();
        { pg8::Gemm g{AV, (bf16_t*)(ws + WA_WDN) + (size_t)L * FF * DM, MTOT, DM, FF, FF, FF, 0}; pg8::StaticOrder S; S.init(MTOT, DM, F.G, F.bid);
          conv_fix_units(F, S, AV, a.in[I_CONVW] + (size_t)L * 3 * FF, a.in[I_CONVB] + (size_t)L * FF, halo, raw0, 0);
          pg8::EpiResid<false> E{nullptr, X, X, modL + 5120, 0}; pg8::gemm_phase(F.lds, g, S, E); }
        GSYNC();
    }

    transpose_matrix(F, a.in[I_WKV], DM, 6144, (bf16_t*)(ws + WB_WKV), 0);
    for (int j = 0; j < 2; ++j) {
        transpose_matrix(F, a.in[I_WQ] + (size_t)j * DM * 3072, DM, 3072, (bf16_t*)(ws + WB_WQ) + (size_t)j * DM * 3072, 0);
        transpose_matrix(F, a.in[I_WO] + (size_t)j * DM * DM, DM, DM, (bf16_t*)(ws + WB_WO) + (size_t)j * DM * DM, 0);
        transpose_matrix<true>(F, a.in[I_WUP] + (size_t)(2 + j) * DM * NUP, DM, NUP, (bf16_t*)(ws + WB_WUP) + (size_t)j * DM * NUP, 0);
        transpose_matrix(F, a.in[I_WDN] + (size_t)(2 + j) * FF * DM, FF, DM, (bf16_t*)(ws + WB_WDN) + (size_t)j * FF * DM, 0);
    }
    __syncthreads();

    for (int c = 0; c < 2; ++c) {
        const int row0 = c * MC;
        bf16_t* H = (bf16_t*)(ws + WB_H); bf16_t* KVc = (bf16_t*)(ws + WB_KV); bf16_t* Qc = (bf16_t*)(ws + WB_Q); bf16_t* AV = (bf16_t*)(ws + WB_AV); float* LSE = (float*)(ws + WB_LSE);
        bf16_t* H2 = (bf16_t*)(ws + WB_H2);
        { const float* mod2 = mod + (size_t)2 * 8 * 6144;
          norm_phase<true>(F, X, H, a.in[I_KVNG], kvmod + 0, kvmod + 1024, 2048, row0, MC);
          norm_phase<true>(F, X, H2, a.in[I_N1G] + 2 * DM, mod2 + 0, mod2 + 1024, 6144, row0, MC); }
        GSYNC();
        { pg8::Gemm g{H, (bf16_t*)(ws + WB_WKV), MC, 6144, DM, DM, DM, 0}; pg8::StaticOrder S; S.init(MC, 6144, F.G, F.bid);
          pg8::EpiQKV E{KVc, (size_t)MC * 1024, 1.0f}; pg8::gemm_phase(F.lds, g, S, E); }
        { pg8::Gemm g{H2, (bf16_t*)(ws + WB_WQ), MC, 3072, DM, DM, DM, 0}; pg8::StaticOrder S; S.init(MC, 3072, F.G, F.bid);
          pg8::EpiQKV E{Qc, (size_t)MC * 1024, 0.125f * LOG2E}; pg8::gemm_phase(F.lds, g, S, E); }
        GSYNC();
        for (int j = 0; j < 2; ++j) {
            const int L = 2 + j; const float* modL = mod + (size_t)L * 8 * 6144;
            if (j == 1) {
                norm_phase<true>(F, X, H, a.in[I_N1G] + L * DM, modL + 0, modL + 1024, 6144, row0, MC);
                GSYNC();
                { pg8::Gemm g{H, (bf16_t*)(ws + WB_WQ) + (size_t)j * DM * 3072, MC, 3072, DM, DM, DM, 0}; pg8::StaticOrder S; S.init(MC, 3072, F.G, F.bid);
                  pg8::EpiQKV E{Qc, (size_t)MC * 1024, 0.125f * LOG2E}; pg8::gemm_phase(F.lds, g, S, E); }
                GSYNC();
            }
            attn_phase(F, Qc, KVc, LSE);
            GSYNC();
            merge_phase(F, Qc, LSE, H);
            GSYNC();
            { pg8::Gemm g{H, (bf16_t*)(ws + WB_WO) + (size_t)j * DM * DM, MC, DM, DM, DM, DM, 0}; pg8::StaticOrder S; S.init(MC, DM, F.G, F.bid);
              pg8::EpiResid<false> E{nullptr, X, X, modL + 2048, row0}; pg8::gemm_phase(F.lds, g, S, E); }
            GSYNC();
            norm_phase<true>(F, X, H, a.in[I_N2G] + L * DM, modL + 3072, modL + 4096, 6144, row0, MC);
            GSYNC();
            { pg8::Gemm g{H, (bf16_t*)(ws + WB_WUP) + (size_t)j * DM * NUP, MC, NUP, DM, DM, DM, 0}; pg8::StaticOrder S; S.init(MC, NUP, F.G, F.bid);
              pg8::EpiConvGate E{AV, a.in[I_CONVW] + (size_t)L * 3 * FF, a.in[I_CONVB] + (size_t)L * FF, halo, raw0, xch}; pg8::gemm_phase(F.lds, g, S, E); }
            GSYNC();
            { pg8::Gemm g{AV, (bf16_t*)(ws + WB_WDN) + (size_t)j * FF * DM, MC, DM, FF, FF, FF, 0}; pg8::StaticOrder S; S.init(MC, DM, F.G, F.bid);
              conv_fix_units(F, S, AV, a.in[I_CONVW] + (size_t)L * 3 * FF, a.in[I_CONVB] + (size_t)L * FF, halo, raw0, row0);
              bf16_t* Xo = (c == 1 && j == 1) ? (bf16_t*)(ws + WS_XTAIL) - (size_t)MC * DM : X;
              pg8::EpiResid<false> E{nullptr, X, Xo, modL + 5120, row0}; pg8::gemm_phase(F.lds, g, S, E); }
            GSYNC();
        }
    }
    final_norm_phase(F, X, 0, a.out, a.in[I_FING], 0, MC);
    GSYNC();
    final_norm_phase(F, (const bf16_t*)(ws + WS_XTAIL), MC, a.out, a.in[I_FING], MC, MTOT);
}

extern "C" void kernel_launch(void* const* d_in, const int* in_sizes, int n_in, void* d_out, int out_size, void* d_ws, size_t ws_size, hipStream_t stream) {
    static int grid = 0;
    if (grid == 0) {
        int dev = 0, cus = 0, per_cu = 0;
        if (n_in != 21 || out_size != MTOT * DM || ws_size < 512 * MiB) { fprintf(stderr, "kernel_launch: unexpected problem (n_in %d, out %d, ws %zu)\n", n_in, out_size, ws_size); grid = -1; return; }
        if (hipGetDevice(&dev) != hipSuccess || hipDeviceGetAttribute(&cus, hipDeviceAttributeMultiprocessorCount, dev) != hipSuccess) { grid = -1; return; }
        if (hipFuncSetAttribute((const void*)mega_fwd, hipFuncAttributeMaxDynamicSharedMemorySize, LDS_BYTES) != hipSuccess) { fprintf(stderr, "kernel_launch: hipFuncSetAttribute failed\n"); grid = -1; return; }
        if (hipOccupancyMaxActiveBlocksPerMultiprocessor(&per_cu, (const void*)mega_fwd, NTHREADS, LDS_BYTES) != hipSuccess || per_cu < 1) { fprintf(stderr, "kernel_launch: occupancy query says %d\n", per_cu); per_cu = 1; }
        (void)hipGetLastError();
        grid = cus;
    }
    if (grid < 0) return;
    Args a{};
    for (int i = 0; i < 21; ++i) a.in[i] = (const float*)d_in[i];
    a.out = (float*)d_out; a.ws = (unsigned char*)d_ws;
    if (hipMemsetAsync((unsigned char*)d_ws + WS_BAR, 0, XCD_BAR_WORDS * 4, stream) != hipSuccess) { fprintf(stderr, "kernel_launch: memset of the barrier words failed\n"); return; }
    void* args[] = {&a};
    hipError_t e = hipLaunchCooperativeKernel((const void*)mega_fwd, dim3(grid), dim3(NTHREADS), args, LDS_BYTES, stream);
    if (e != hipSuccess) fprintf(stderr, "kernel_launch: cooperative launch failed: %s (grid %d)\n", hipGetErrorString(e), grid);
}
```

```cpp
#include <hip/hip_runtime.h>
#include <hip/hip_cooperative_groups.h>
#include <cstdio>
#include <cstdint>
#include <cmath>
namespace cg = cooperative_groups;

#define LAS __attribute__((address_space(3)))
typedef unsigned short bf16_t;
typedef short bf16x8 __attribute__((ext_vector_type(8)));
typedef short s16x4 __attribute__((ext_vector_type(4)));
typedef float f32x4 __attribute__((ext_vector_type(4)));
typedef float f32x16 __attribute__((ext_vector_type(16)));
typedef unsigned u32x4 __attribute__((ext_vector_type(4)));
typedef unsigned u32x2 __attribute__((ext_vector_type(2)));

constexpr int SEQ = 4096, DM = 1024, NB = 8, MTOT = NB * SEQ, FF = 2816, NUP = 2 * FF, DEPTH = 4;
constexpr int MC = 16384;
constexpr float EPS = 1e-6f;
constexpr float LOG2E = 1.4426950408889634f;
constexpr int NTHREADS = 512, NWAVES = 8;
constexpr int LDS_BYTES = 147456;

constexpr size_t MiB = 1u << 20;
constexpr size_t WS_MOD = 0;
constexpr size_t WS_KVMOD = 4 * 8 * 6144 * 4;
constexpr size_t WS_BAR = 896 * 1024;
constexpr size_t WA_WIN = 1 * MiB;
constexpr size_t WA_WGRP = 5 * MiB;
constexpr size_t WA_WOUT = 6 * MiB;
constexpr size_t WA_WUP = 10 * MiB;
constexpr size_t WA_WDN = 32 * MiB;
constexpr size_t WA_H = 44 * MiB;
constexpr size_t WA_AV = 108 * MiB;
constexpr size_t WA_U = 108 * MiB, WA_PB = 172 * MiB, WA_Y = 236 * MiB;
constexpr size_t WB_WKV = 1 * MiB;
constexpr size_t WB_WQ = 13 * MiB;
constexpr size_t WB_WO = 25 * MiB;
constexpr size_t WB_WUP = 29 * MiB;
constexpr size_t WB_WDN = 51 * MiB;
constexpr size_t WB_H = 62 * MiB;
constexpr size_t WB_LSE = 94 * MiB;
constexpr size_t WB_KV = 97 * MiB;
constexpr size_t WB_Q = 289 * MiB;
constexpr size_t WB_AV = 289 * MiB;
constexpr size_t WB_H2 = 480 * MiB;
constexpr size_t WS_XTAIL = 128 * MiB;
constexpr size_t WS_HALO = 470 * MiB;
constexpr size_t WS_RAW0 = 474 * MiB;

__device__ __forceinline__ unsigned f2bf(float f) { unsigned u = __builtin_bit_cast(unsigned, f); return (u + 0x7fffu + ((u >> 16) & 1u)) >> 16; }
__device__ __forceinline__ unsigned cvt_pk_bf16(float lo, float hi) { unsigned r; asm volatile("v_cvt_pk_bf16_f32 %0, %1, %2" : "=v"(r) : "v"(lo), "v"(hi)); return r; }
__device__ __forceinline__ unsigned pk2(float lo, float hi) { unsigned r; asm("v_cvt_pk_bf16_f32 %0, %1, %2" : "=v"(r) : "v"(lo), "v"(hi)); return r; }
__device__ __forceinline__ float bflo(unsigned w) { return __builtin_bit_cast(float, w << 16); }
__device__ __forceinline__ float bfhi(unsigned w) { return __builtin_bit_cast(float, w & 0xffff0000u); }
__device__ __forceinline__ float wave_sum(float v) {
#pragma unroll
    for (int o = 1; o < 64; o <<= 1) v += __shfl_xor(v, o);
    return v;
}
#define LDS_WAIT() asm volatile("s_waitcnt lgkmcnt(0)" ::: "memory")

namespace pg8 {
constexpr int BM = 256, BK = 64, HALF = 128, HTB = HALF * BK * 2, STAGE_BYTES = 8 * HTB, NXCD = 8, WGM = 8;
__host__ __device__ __forceinline__ int lds_byte(int r, int c) { const int st = (r >> 4) * 2 + (c >> 5), rr = r & 15, cc = c & 31, ob = rr * 64 + cc * 2; return st * 1024 + (ob ^ (((ob >> 9) & 1) << 5)); }
__host__ __device__ __forceinline__ void stage_rc(int b, int& R, int& C) { const int st = b / 1024, sb = b % 1024, swz = sb ^ (((sb >> 9) & 1) << 5); R = (st >> 1) * 16 + swz / 64; C = (st & 1) * 32 + (swz % 64) / 2; }
__host__ __device__ __forceinline__ int perm32(int rho) { const int n = rho >> 4, i = rho & 15; return 8 * (i >> 2) + 4 * n + (i & 3); }

struct Unit { int pm, pn; };
struct Gemm { const bf16_t* A; const bf16_t* Bt; int M, N, K, lda, ldb, a_pn_koff; };

struct StaticOrder {
    int nM, nN, nwg, G, c;
    __device__ void init(int M, int N, int G_, int c_) { nM = M / BM; nN = N / BM; nwg = nM * nN; G = G_; c = c_; }
    __device__ bool next(int i, Unit& u) const {
        const long L = (long)i * G + c; if (L >= nwg) return false;
        int wgid = (int)L; { const int q = nwg / NXCD, r = nwg % NXCD, xcd = wgid % NXCD, off = wgid / NXCD; wgid = (xcd < r ? xcd * (q + 1) : r * (q + 1) + (xcd - r) * q) + off; }
        const int nig = WGM * nN, gid = wgid / nig, fm = gid * WGM, gsz = (nM - fm) < WGM ? (nM - fm) : WGM;
        u.pm = fm + ((wgid % nig) % gsz); u.pn = (wgid % nig) / gsz; return true;
    }
};

struct EpiBf16 {
    static constexpr bool PERM = true;
    bf16_t* O; int ldc; const float* cscale;
    __device__ __forceinline__ void operator()(const f32x4 (&acc)[2][2][4][2], const Unit& u, int wr, int wc, int fr, int fq) const {
        const int row0 = u.pm * BM + wr * 64 + fr; const int col0 = u.pn * BM + wc * 32 + 8 * fq;
        f32x4 sv[2][2];
#pragma unroll
        for (int bj = 0; bj < 2; ++bj)
#pragma unroll
            for (int n = 0; n < 2; ++n) sv[bj][n] = cscale ? *(const f32x4*)(cscale + col0 + bj * HALF + 4 * n) : (f32x4){1.f, 1.f, 1.f, 1.f};
#pragma unroll
        for (int ai = 0; ai < 2; ++ai)
#pragma unroll
            for (int m = 0; m < 4; ++m) { bf16_t* rowp = O + (size_t)(row0 + ai * HALF + m * 16) * ldc + col0;
#pragma unroll
                for (int bj = 0; bj < 2; ++bj) { const f32x4 v0 = acc[ai][bj][m][0] * sv[bj][0], v1 = acc[ai][bj][m][1] * sv[bj][1];
                    u32x4 w; w.x = cvt_pk_bf16(v0[0], v0[1]); w.y = cvt_pk_bf16(v0[2], v0[3]); w.z = cvt_pk_bf16(v1[0], v1[1]); w.w = cvt_pk_bf16(v1[2], v1[3]);
                    *(u32x4*)(rowp + bj * HALF) = w; } }
    }
};
struct EpiPoolU {
    static constexpr bool PERM = true;
    bf16_t* U; bf16_t* PB;
    __device__ __forceinline__ void operator()(const f32x4 (&acc)[2][2][4][2], const Unit& u, int wr, int wc, int fr, int fq) const {
        const int row0 = u.pm * BM + wr * 64 + fr; const int col0 = u.pn * BM + wc * 32 + 8 * fq;
#pragma unroll
        for (int ai = 0; ai < 2; ++ai)
#pragma unroll
            for (int m = 0; m < 4; ++m) { bf16_t* rowp = U + (size_t)(row0 + ai * HALF + m * 16) * DM + col0;
#pragma unroll
                for (int bj = 0; bj < 2; ++bj) { const f32x4 v0 = acc[ai][bj][m][0], v1 = acc[ai][bj][m][1];
                    u32x4 w; w.x = cvt_pk_bf16(v0[0], v0[1]); w.y = cvt_pk_bf16(v0[2], v0[3]); w.z = cvt_pk_bf16(v1[0], v1[1]); w.w = cvt_pk_bf16(v1[2], v1[3]);
                    *(u32x4*)(rowp + bj * HALF) = w; } }
        asm volatile("s_waitcnt vmcnt(0)" ::: "memory"); __builtin_amdgcn_s_barrier(); asm volatile("" ::: "memory");
        const int tid = ((wr * 4 + wc) * 64) + fq * 16 + fr, ch = tid & 31, seg = tid >> 5;
        if (seg >= 1) {
            const int w = 2 << u.pn, col = u.pn * BM + ch * 8; const size_t t0 = (size_t)u.pm * BM + seg * 16;
            const float inv = 1.f / (float)w;
            float sum[8];
#pragma unroll
            for (int e = 0; e < 8; ++e) sum[e] = 0.f;
            for (int j = 1; j <= w; ++j) { const u32x4 x = *(const u32x4*)(U + (t0 - j) * DM + col);
                sum[0] += bflo(x.x); sum[1] += bfhi(x.x); sum[2] += bflo(x.y); sum[3] += bfhi(x.y); sum[4] += bflo(x.z); sum[5] += bfhi(x.z); sum[6] += bflo(x.w); sum[7] += bfhi(x.w); }
#pragma unroll
            for (int hb = 0; hb < 2; ++hb) {
                u32x4 xs[8], ys[8];
#pragma unroll
                for (int k = 0; k < 8; ++k) { const size_t t = t0 + hb * 8 + k; xs[k] = *(const u32x4*)(U + t * DM + col); ys[k] = *(const u32x4*)(U + (t - w) * DM + col); }
#pragma unroll
                for (int k = 0; k < 8; ++k) { const size_t t = t0 + hb * 8 + k; const u32x4 x = xs[k], y = ys[k];
                    const float ut[8] = {bflo(x.x), bfhi(x.x), bflo(x.y), bfhi(x.y), bflo(x.z), bfhi(x.z), bflo(x.w), bfhi(x.w)};
                    const float ul[8] = {bflo(y.x), bfhi(y.x), bflo(y.y), bfhi(y.y), bflo(y.z), bfhi(y.z), bflo(y.w), bfhi(y.w)};
                    float o[8];
#pragma unroll
                    for (int e = 0; e < 8; ++e) { sum[e] += ut[e] - ul[e]; o[e] = sum[e] * inv - ut[e]; }
                    u32x4 wv; wv.x = cvt_pk_bf16(o[0], o[1]); wv.y = cvt_pk_bf16(o[2], o[3]); wv.z = cvt_pk_bf16(o[4], o[5]); wv.w = cvt_pk_bf16(o[6], o[7]);
                    *(u32x4*)(PB + t * DM + col) = wv; }
            }
        }
    }
};
struct EpiQKV {
    static constexpr bool PERM = true;
    bf16_t* O; size_t mat_stride; float scale;
    __device__ __forceinline__ void operator()(const f32x4 (&acc)[2][2][4][2], const Unit& u, int wr, int wc, int fr, int fq) const {
        const int colt = u.pn * BM; const int t = colt >> 10; const int g = t % 3; const int sh = 2 * g; const int dm1 = (1 << sh) - 1;
        const int hd0 = ((colt & 1023) >> 6) + (wc >> 1);
        bf16_t* base = O + (size_t)t * mat_stride + (size_t)hd0 * MC * 64 + (wc & 1) * 32 + 8 * fq;
        const int row0 = u.pm * BM + wr * 64 + fr;
#pragma unroll
        for (int ai = 0; ai < 2; ++ai)
#pragma unroll
            for (int m = 0; m < 4; ++m) { const int r = row0 + ai * HALF + m * 16; const int tt = r & 4095;
                const int dest = (r & ~4095) + ((tt & dm1) << (12 - sh)) + (tt >> sh);
                bf16_t* rowp = base + (size_t)dest * 64;
#pragma unroll
                for (int bj = 0; bj < 2; ++bj) { const f32x4 v0 = acc[ai][bj][m][0] * scale, v1 = acc[ai][bj][m][1] * scale;
                    u32x4 w; w.x = cvt_pk_bf16(v0[0], v0[1]); w.y = cvt_pk_bf16(v0[2], v0[3]); w.z = cvt_pk_bf16(v1[0], v1[1]); w.w = cvt_pk_bf16(v1[2], v1[3]);
                    *(u32x4*)(rowp + (size_t)bj * 2 * MC * 64) = w; } }
    }
};
template <bool BASE_F32>
struct EpiResid {
    static constexpr bool PERM = true;
    const float* base32; const bf16_t* base16; bf16_t* out; const float* gate; int row_base;
    __device__ __forceinline__ void operator()(const f32x4 (&acc)[2][2][4][2], const Unit& u, int wr, int wc, int fr, int fq) const {
        const int rowt = row_base + u.pm * BM; const int b = rowt >> 12;
        const int col0 = u.pn * BM + wc * 32 + 8 * fq; const int row0 = rowt + wr * 64 + fr;
        f32x4 gv[2][2];
#pragma unroll
        for (int bj = 0; bj < 2; ++bj)
#pragma unroll
            for (int n = 0; n < 2; ++n) gv[bj][n] = *(const f32x4*)(gate + (size_t)b * 6144 + col0 + bj * HALF + 4 * n);
        constexpr int NG = BASE_F32 ? 2 : 4;
#pragma unroll
        for (int rd = 0; rd < 8 / NG; ++rd) {
            u32x4 bw[NG][2]; f32x4 bf[BASE_F32 ? NG : 1][2][2];
#pragma unroll
            for (int mi = 0; mi < NG; ++mi) { const int gi = rd * NG + mi, ai = gi >> 2, m = gi & 3; const size_t off = (size_t)(row0 + ai * HALF + m * 16) * DM + col0;
#pragma unroll
                for (int bj = 0; bj < 2; ++bj) {
                    if (BASE_F32) { bf[BASE_F32 ? mi : 0][bj][0] = *(const f32x4*)(base32 + off + bj * HALF); bf[BASE_F32 ? mi : 0][bj][1] = *(const f32x4*)(base32 + off + bj * HALF + 4); }
                    else bw[mi][bj] = *(const u32x4*)(base16 + off + bj * HALF); } }
            asm volatile("" ::: "memory");
#pragma unroll
            for (int mi = 0; mi < NG; ++mi) { const int gi = rd * NG + mi, ai = gi >> 2, m = gi & 3; const size_t off = (size_t)(row0 + ai * HALF + m * 16) * DM + col0;
#pragma unroll
                for (int bj = 0; bj < 2; ++bj) {
                    f32x4 b0, b1;
                    if (BASE_F32) { b0 = bf[BASE_F32 ? mi : 0][bj][0]; b1 = bf[BASE_F32 ? mi : 0][bj][1]; }
                    else { const u32x4 w = bw[mi][bj]; b0 = (f32x4){bflo(w.x), bfhi(w.x), bflo(w.y), bfhi(w.y)}; b1 = (f32x4){bflo(w.z), bfhi(w.z), bflo(w.w), bfhi(w.w)}; }
                    const f32x4 v0 = b0 + gv[bj][0] * acc[ai][bj][m][0], v1 = b1 + gv[bj][1] * acc[ai][bj][m][1];
                    u32x4 w; w.x = cvt_pk_bf16(v0[0], v0[1]); w.y = cvt_pk_bf16(v0[2], v0[3]); w.z = cvt_pk_bf16(v1[0], v1[1]); w.w = cvt_pk_bf16(v1[2], v1[3]);
                    *(u32x4*)(out + off + bj * HALF) = w; } }
            asm volatile("" ::: "memory");
        }
    }
};

struct EpiConvGate {
    static constexpr bool PERM = true;
    bf16_t* G; const float* cw; const float* cb; float* halo; float* raw0; LAS float* xch;
    __device__ __forceinline__ void operator()(const f32x4 (&acc)[2][2][4][2], const Unit& u, int wr, int wc, int fr, int fq) const {
        const int lane = threadIdx.x & 63;
        const int colh = u.pn * 128 + wc * 32 + 8 * fq;
#define EA(ai, m, e) acc[ai][0][m][(e) >> 2][(e) & 3]
#define EV(ai, m, e) acc[ai][1][m][(e) >> 2][(e) & 3]
        if (fr >= 14) {
#pragma unroll
            for (int ai = 0; ai < 2; ++ai) { LAS float* xp = xch + ((((ai * 2 + wr) * 4 + wc) * 2 + (fr - 14)) * 4 + fq) * 8;
                *(LAS f32x4*)xp = acc[ai][0][3][0]; *(LAS f32x4*)(xp + 4) = acc[ai][0][3][1]; }
            if (wr == 1) { float* hp = halo + ((size_t)u.pm * 2 + (fr - 14)) * FF + colh; *(f32x4*)hp = acc[1][0][3][0]; *(f32x4*)(hp + 4) = acc[1][0][3][1]; }
        }
        asm volatile("s_waitcnt lgkmcnt(0)" ::: "memory"); __builtin_amdgcn_s_barrier(); asm volatile("" ::: "memory");
        f32x4 w0[2], w1[2], w2[2], bb[2];
#pragma unroll
        for (int nh = 0; nh < 2; ++nh) { const int colq = colh + 4 * nh; w0[nh] = *(const f32x4*)(cw + colq); w1[nh] = *(const f32x4*)(cw + FF + colq); w2[nh] = *(const f32x4*)(cw + 2 * FF + colq); bb[nh] = *(const f32x4*)(cb + colq); }
#pragma unroll
        for (int ai = 0; ai < 2; ++ai) {
            f32x4 q1[2], q2[2];
            const bool seam = (ai == 0 && wr == 0);
            if (!seam) { const int pai = wr == 1 ? ai : 0, pwr = wr == 1 ? 0 : 1; const LAS float* xp = xch + ((((pai * 2 + pwr) * 4 + wc) * 2) * 4 + fq) * 8;
#pragma unroll
                for (int nh = 0; nh < 2; ++nh) { const f32x4 p14 = *(const LAS f32x4*)(xp + 4 * nh), p15 = *(const LAS f32x4*)(xp + 32 + 4 * nh); q1[nh] = p15; q2[nh] = (fr == 1) ? p15 : p14; } }
            else { q1[0] = (f32x4){0.f, 0.f, 0.f, 0.f}; q1[1] = q1[0]; q2[0] = q1[0]; q2[1] = q1[0]; }
#pragma unroll
            for (int m = 0; m < 4; ++m) {
                u32x4 wout;
#pragma unroll
                for (int nh = 0; nh < 2; ++nh) {
                    const f32x4 av = acc[ai][0][m][nh], vv = acc[ai][1][m][nh];
                    f32x4 o;
#pragma unroll
                    for (int e = 0; e < 4; ++e) {
                        const float ac = av[e];
                        const float c1 = __builtin_bit_cast(float, __builtin_amdgcn_mov_dpp(__builtin_bit_cast(int, ac), 0x121, 0xF, 0xF, true));
                        const float c2 = __builtin_bit_cast(float, __builtin_amdgcn_mov_dpp(__builtin_bit_cast(int, ac), 0x122, 0xF, 0xF, true));
                        const float pr1 = fr >= 1 ? c1 : q1[nh][e];
                        const float pr2 = fr >= 2 ? c2 : q2[nh][e];
                        const float y = __builtin_fmaf(w2[nh][e], ac, __builtin_fmaf(w1[nh][e], pr1, __builtin_fmaf(w0[nh][e], pr2, bb[nh][e])));
                        o[e] = y * __builtin_amdgcn_rcpf(1.f + __builtin_amdgcn_exp2f(-LOG2E * y)) * vv[e];
                        q1[nh][e] = c1; q2[nh][e] = c2;
                    }
                    if (nh == 0) { wout.x = cvt_pk_bf16(o[0], o[1]); wout.y = cvt_pk_bf16(o[2], o[3]); } else { wout.z = cvt_pk_bf16(o[0], o[1]); wout.w = cvt_pk_bf16(o[2], o[3]); }
                }
                const int trow = ai * HALF + wr * 64 + m * 16 + fr;
                if (seam && m == 0 && fr < 2) {
                    float* rp = raw0 + ((size_t)u.pm * 2 + fr) * NUP + colh;
                    *(f32x4*)rp = acc[0][0][0][0]; *(f32x4*)(rp + 4) = acc[0][0][0][1]; *(f32x4*)(rp + FF) = acc[0][1][0][0]; *(f32x4*)(rp + FF + 4) = acc[0][1][0][1];
                } else *(u32x4*)(G + (size_t)(u.pm * BM + trow) * FF + colh) = wout;
            }
        }
#undef EA
#undef EV
    }
};

template <class Epi, class Sched>
__device__ __forceinline__ void gemm_phase(LAS unsigned char* lds, const Gemm g, const Sched& S, const Epi& E) {
    int tid_ = threadIdx.x; asm volatile("" : "+v"(tid_));
    const int tid = tid_, wid = __builtin_amdgcn_readfirstlane(tid >> 6), lane = tid & 63, wr = wid >> 2, wc = wid & 3, fr = lane & 15, fq = lane >> 4;
    const int K = g.K, nt = K / BK;
    unsigned voffA[2], voffB[2];
#pragma unroll
    for (int i = 0; i < 2; ++i) { int R, C; stage_rc(tid * 16 + i * 8192, R, C); const int Rb = Epi::PERM ? ((R & ~31) + perm32(R & 31)) : R;
        voffA[i] = (unsigned)(R * g.lda + C) * 2u; voffB[i] = (unsigned)(Rb * g.ldb + C) * 2u; }
    const size_t kstep = (size_t)(BK * 2);
    const size_t hstepA = (size_t)HALF * g.lda * 2, hstepB = (size_t)HALF * g.ldb * 2;
    const size_t tstepA = 2 * hstepA, tstepB = 2 * hstepB;
    const unsigned ldsw = (unsigned)wid * 1024u;
    const int aoff = lds_byte(wr * 64 + fr, fq * 8), boff = lds_byte(wc * 32 + fr, fq * 8);
#define PG8_SA(b, h) (((b) * 2 + (h)) * HTB)
#define PG8_SB(b, h) ((4 + (b) * 2 + (h)) * HTB)
#define PG8_STAGE(bufoff, gbase, voff) do { _Pragma("unroll") for (int _i = 0; _i < 2; ++_i) \
        __builtin_amdgcn_global_load_lds((const unsigned*)((const char*)(gbase) + (voff)[_i]), (LAS unsigned*)(lds + (bufoff) + ldsw + _i * 8192), 16, 0, 0); } while (0)
#define PG8_LDA(dst, b, h) do { _Pragma("unroll") for (int m = 0; m < 4; ++m) _Pragma("unroll") for (int k = 0; k < 2; ++k) dst[m][k] = *(const LAS bf16x8*)(lds + PG8_SA(b, h) + aoff + m * 2048 + k * 1024); } while (0)
#define PG8_LDB(dst, b, h) do { _Pragma("unroll") for (int n = 0; n < 2; ++n) _Pragma("unroll") for (int k = 0; k < 2; ++k) dst[n][k] = *(const LAS bf16x8*)(lds + PG8_SB(b, h) + boff + n * 2048 + k * 1024); } while (0)
#define PG8_MMA(ai, bj, At, Bt) do { __builtin_amdgcn_s_setprio(3); _Pragma("unroll") for (int m = 0; m < 4; ++m) _Pragma("unroll") for (int n = 0; n < 2; ++n) _Pragma("unroll") for (int k = 0; k < 2; ++k) \
        acc[ai][bj][m][n] = __builtin_amdgcn_mfma_f32_16x16x32_bf16(Bt[n][k], At[m][k], acc[ai][bj][m][n], 0, 0, 0); __builtin_amdgcn_s_setprio(0); } while (0)
#define PG8_WAIT_V(n) asm volatile("s_waitcnt vmcnt(" #n ")" ::: "memory")
#define PG8_WAIT_L(n) asm volatile("s_waitcnt lgkmcnt(" #n ")" ::: "memory")
#define PG8_BAR __builtin_amdgcn_s_barrier()
#define PG8_SCHED __builtin_amdgcn_sched_barrier(0)
#define PG8_BASEA(un) ((const char*)g.A + (size_t)(un).pm * tstepA + (size_t)(un).pn * (size_t)g.a_pn_koff * 2)
#define PG8_BASEB(un) ((const char*)g.Bt + (size_t)(un).pn * tstepB)
    Unit cur, nxt; int ui = 0;
    if (!S.next(0, cur)) return;
    f32x4 acc[2][2][4][2];
#pragma unroll
    for (int a = 0; a < 2; ++a)
#pragma unroll
        for (int b = 0; b < 2; ++b)
#pragma unroll
            for (int m = 0; m < 4; ++m)
#pragma unroll
                for (int n = 0; n < 2; ++n) acc[a][b][m][n] = (f32x4){0.f, 0.f, 0.f, 0.f};
    bf16x8 At[4][2], B0[2][2], B1[2][2];
    const char* cA = PG8_BASEA(cur); const char* cB = PG8_BASEB(cur);
    PG8_STAGE(PG8_SB(0, 0), cB, voffB); PG8_STAGE(PG8_SB(0, 1), cB + hstepB, voffB); PG8_STAGE(PG8_SA(0, 0), cA, voffA); PG8_STAGE(PG8_SA(0, 1), cA + hstepA, voffA);
    if (wr == 1) PG8_BAR;
    PG8_WAIT_V(2); PG8_BAR;
    PG8_STAGE(PG8_SB(1, 0), cB + kstep, voffB); PG8_STAGE(PG8_SA(1, 0), cA + kstep, voffA); PG8_STAGE(PG8_SB(1, 1), cB + hstepB + kstep, voffB);
    PG8_WAIT_V(6); PG8_BAR;
    for (;;) {
        const bool has_next = S.next(ui + 1, nxt);
        const char* nA = has_next ? PG8_BASEA(nxt) : cA; const char* nB = has_next ? PG8_BASEB(nxt) : cB;
        for (int t = 0; t < nt; t += 2) {
            const bool last = (t == nt - 2);
            const char* a1 = cA + (size_t)(t + 1) * kstep;
            const char* a2 = last ? nA : cA + (size_t)(t + 2) * kstep; const char* b2 = last ? nB : cB + (size_t)(t + 2) * kstep;
            const char* a3 = a2 + kstep; const char* b3 = b2 + kstep;
            PG8_LDB(B0, 0, 0); PG8_LDB(B1, 0, 1); PG8_SCHED; PG8_LDA(At, 0, 0); PG8_STAGE(PG8_SA(1, 1), a1 + hstepA, voffA);
            PG8_WAIT_V(8); PG8_WAIT_L(0); PG8_BAR; PG8_MMA(0, 0, At, B0); PG8_MMA(0, 1, At, B1); PG8_BAR; PG8_SCHED;
            PG8_LDA(At, 0, 1); PG8_STAGE(PG8_SB(0, 0), b2, voffB); PG8_STAGE(PG8_SB(0, 1), b2 + hstepB, voffB); PG8_STAGE(PG8_SA(0, 0), a2, voffA);
            PG8_WAIT_V(8); PG8_WAIT_L(0); PG8_BAR; PG8_MMA(1, 0, At, B0); PG8_MMA(1, 1, At, B1); PG8_BAR; PG8_SCHED;
            PG8_LDB(B0, 1, 0); PG8_LDB(B1, 1, 1); PG8_SCHED; PG8_LDA(At, 1, 0); PG8_STAGE(PG8_SA(0, 1), a2 + hstepA, voffA);
            PG8_WAIT_V(8); PG8_WAIT_L(0); PG8_BAR; PG8_MMA(0, 0, At, B0); PG8_MMA(0, 1, At, B1); PG8_BAR; PG8_SCHED;
            PG8_LDA(At, 1, 1); PG8_STAGE(PG8_SB(1, 0), b3, voffB); PG8_STAGE(PG8_SB(1, 1), b3 + hstepB, voffB); PG8_STAGE(PG8_SA(1, 0), a3, voffA);
            PG8_WAIT_V(8); PG8_WAIT_L(0); PG8_BAR; PG8_MMA(1, 0, At, B0); PG8_MMA(1, 1, At, B1); PG8_BAR; PG8_SCHED;
        }
        if (wr == 0) PG8_BAR;
        E(acc, cur, wr, wc, fr, fq);
        if (!has_next) break;
#pragma unroll
        for (int a = 0; a < 2; ++a)
#pragma unroll
            for (int b = 0; b < 2; ++b)
#pragma unroll
                for (int m = 0; m < 4; ++m)
#pragma unroll
                    for (int n = 0; n < 2; ++n) acc[a][b][m][n] = (f32x4){0.f, 0.f, 0.f, 0.f};
        cur = nxt; cA = nA; cB = nB; ++ui;
        if (wr == 1) PG8_BAR;
    }
    PG8_WAIT_V(0);
    PG8_BAR;
#undef PG8_SA
#undef PG8_SB
#undef PG8_STAGE
#undef PG8_LDA
#undef PG8_LDB
#undef PG8_MMA
#undef PG8_WAIT_V
#undef PG8_WAIT_L
#undef PG8_BAR
#undef PG8_SCHED
#undef PG8_BASEA
#undef PG8_BASEB
}
}

struct Ctx { LAS unsigned char* lds; int tid, lane, wave, bid, G; };
__device__ __forceinline__ Ctx relaunder(const Ctx& F0) { Ctx F = F0; int t = threadIdx.x; asm volatile("" : "+v"(t)); F.tid = t; F.lane = t & 63; F.wave = __builtin_amdgcn_readfirstlane(t >> 6); return F; }

template <bool AVPERM>
__device__ __forceinline__ void transpose_item(const float* W, int K, int N, bf16_t* WT, int row_off, LAS float* scr, int item, int lane) {
    const int nblk = N / 32, kb = item / nblk, nb = item % nblk, k0 = 64 * kb, n0 = 32 * nb;
    const int d0 = AVPERM ? (n0 < FF ? (n0 >> 7) * 256 + (n0 & 127) : ((n0 - FF) >> 7) * 256 + 128 + ((n0 - FF) & 127)) : n0;
    float wv[32];
#pragma unroll
    for (int i = 0; i < 32; ++i) { const int kk = 2 * i + (lane >> 5); wv[i] = W[(size_t)(k0 + kk) * N + n0 + (lane & 31)]; }
#pragma unroll
    for (int i = 0; i < 32; ++i) { const int kk = 2 * i + (lane >> 5); scr[kk * 33 + (lane & 31)] = wv[i]; }
    LDS_WAIT(); asm volatile("" ::: "memory");
    const int c = lane & 7;
#pragma unroll
    for (int j = 0; j < 4; ++j) { const int n = (lane >> 3) + 8 * j; const LAS float* s = scr + (8 * c) * 33 + n;
        u32x4 o; o.x = pk2(s[0 * 33], s[1 * 33]); o.y = pk2(s[2 * 33], s[3 * 33]); o.z = pk2(s[4 * 33], s[5 * 33]); o.w = pk2(s[6 * 33], s[7 * 33]);
        *(u32x4*)(WT + (size_t)(row_off + d0 + n) * K + k0 + 8 * c) = o; }
    LDS_WAIT(); asm volatile("" ::: "memory");
}
template <bool AVPERM = false>
__device__ __forceinline__ void transpose_matrix(const Ctx& F0, const float* W, int K, int N, bf16_t* WT, int row_off) {
    const Ctx F = relaunder(F0);
    LAS float* scr = (LAS float*)(F.lds + F.wave * 16384);
    const int gw = F.bid * NWAVES + F.wave, NGW = F.G * NWAVES, items = (K / 64) * (N / 32);
    for (int it = gw; it < items; it += NGW) transpose_item<AVPERM>(W, K, N, WT, row_off, scr, it, F.lane);
}

__device__ __forceinline__ void unpack8(const u32x4 w, float (&f)[8]) { f[0] = bflo(w.x); f[1] = bfhi(w.x); f[2] = bflo(w.y); f[3] = bfhi(w.y); f[4] = bflo(w.z); f[5] = bfhi(w.z); f[6] = bflo(w.w); f[7] = bfhi(w.w); }
__device__ __forceinline__ u32x4 pack8(const float (&f)[8]) { u32x4 w; w.x = pk2(f[0], f[1]); w.y = pk2(f[2], f[3]); w.z = pk2(f[4], f[5]); w.w = pk2(f[6], f[7]); return w; }

__device__ __forceinline__ void fold_pool_weights(const Ctx& F0, const float* wgrp, const float* pscale, const float* wout, bf16_t* WT) {
    const Ctx F = relaunder(F0);
    LAS float* WgS = (LAS float*)F.lds;
    LAS float* WoS = WgS + 4096;
    __syncthreads();
    for (int t = F.bid; t < 512; t += F.G) {
        const int L = t >> 8, kt = (t >> 4) & 15, nt = t & 15, k0 = kt * 64, n0 = nt * 64, g = k0 >> 8;
        const float* Wg = wgrp + (size_t)(L * 4 + g) * 65536 + (size_t)(k0 & 255) * 256;
        const float* Wo = wout + (size_t)L * DM * DM + (size_t)(g * 256) * DM + n0;
        const float* sc = pscale + L * DM + g * 256;
        const int n = F.tid & 63, kg = F.tid >> 6;
        float acc[8];
#pragma unroll
        for (int e = 0; e < 8; ++e) acc[e] = 0.f;
        for (int j0 = 0; j0 < 256; j0 += 64) {
#pragma unroll
            for (int i = 0; i < 8; ++i) { const int idx = F.tid + NTHREADS * i, r = idx >> 6, c = idx & 63;
                WgS[r * 64 + c] = Wg[(size_t)r * 256 + j0 + c];
                WoS[r * 64 + c] = Wo[(size_t)(j0 + r) * DM + c] * sc[j0 + r]; }
            __syncthreads();
#pragma unroll 8
            for (int j = 0; j < 64; ++j) { const float b = WoS[j * 64 + n];
#pragma unroll
                for (int e = 0; e < 8; ++e) acc[e] += WgS[(8 * kg + e) * 64 + j] * b; }
            __syncthreads();
        }
        *(u32x4*)(WT + (size_t)L * DM * DM + (size_t)(n0 + n) * DM + k0 + 8 * kg) = pack8(acc);
    }
}

__device__ __forceinline__ void mod_phase(const Ctx& F0, const float* c, const float* ada_w, const float* ada_b, const float* kv_ada_w, const float* kv_ada_b, float* mod, float* kvmod) {
    const Ctx F = relaunder(F0);
    LAS float* condT = (LAS float*)(F.lds + 131072 - 49152);
    LAS float* part = condT + 8192;
    __syncthreads();
    for (int i = F.tid; i < 8192; i += NTHREADS) { const int b = i >> 10, k = i & 1023; const float v = c[i]; condT[k * 8 + b] = v / (1.f + __expf(-v)); }
    __syncthreads();
    for (int it = F.bid; it < 416; it += F.G) {
        const float* W; const float* bias; float* outp; int N, cb;
        if (it < 384) { const int L = it / 96; cb = it % 96; W = ada_w + (size_t)L * 1024 * 6144; N = 6144; bias = ada_b + L * 6144; outp = mod + (size_t)L * 8 * 6144; }
        else { cb = it - 384; W = kv_ada_w; N = 2048; bias = kv_ada_b; outp = kvmod; }
        const int cl = F.tid & 63, kq = F.tid >> 6, col = cb * 64 + cl;
        float a0 = 0.f, a1 = 0.f, a2 = 0.f, a3 = 0.f, a4 = 0.f, a5 = 0.f, a6 = 0.f, a7 = 0.f;
#pragma unroll 16
        for (int k = kq * 128; k < kq * 128 + 128; ++k) {
            const float w = W[(size_t)k * N + col]; const f32x4 c0 = *(const LAS f32x4*)(condT + k * 8), c1 = *(const LAS f32x4*)(condT + k * 8 + 4);
            a0 += w * c0[0]; a1 += w * c0[1]; a2 += w * c0[2]; a3 += w * c0[3]; a4 += w * c1[0]; a5 += w * c1[1]; a6 += w * c1[2]; a7 += w * c1[3];
        }
        part[(kq * 8 + 0) * 64 + cl] = a0; part[(kq * 8 + 1) * 64 + cl] = a1; part[(kq * 8 + 2) * 64 + cl] = a2; part[(kq * 8 + 3) * 64 + cl] = a3;
        part[(kq * 8 + 4) * 64 + cl] = a4; part[(kq * 8 + 5) * 64 + cl] = a5; part[(kq * 8 + 6) * 64 + cl] = a6; part[(kq * 8 + 7) * 64 + cl] = a7;
        __syncthreads();
        { const int b = F.tid >> 6; float s = bias[cb * 64 + cl];
#pragma unroll
          for (int q = 0; q < 8; ++q) s += part[(q * 8 + b) * 64 + cl];
          outp[(size_t)b * N + cb * 64 + cl] = s; }
        __syncthreads();
    }
}

template <bool XBF16>
__device__ __forceinline__ void norm_phase(const Ctx& F0, const void* Xv, bf16_t* H, const float* g, const float* shift, const float* scale, int bstride, int row0, int nrows) {
    const Ctx F = relaunder(F0);
    const int gw = F.bid * NWAVES + F.wave, NGW = F.G * NWAVES;
    const int rpw = (nrows + NGW - 1) / NGW;
    int r = row0 + gw * rpw; const int rend = min(row0 + nrows, r + rpw);
    int curb = -1; f32x4 gs[4], shv[4];
    for (; r < rend; ++r) {
        const int b = r >> 12;
        if (b != curb) { curb = b;
#pragma unroll
            for (int j = 0; j < 4; ++j) { const int col = 4 * F.lane + 256 * j; const f32x4 gg = *(const f32x4*)(g + col), sc = *(const f32x4*)(scale + (size_t)b * bstride + col);
                gs[j] = gg * (sc + 1.f); shv[j] = *(const f32x4*)(shift + (size_t)b * bstride + col); } }
        f32x4 v[4]; float ss = 0.f;
        if (XBF16) { const u32x2* xr = (const u32x2*)((const bf16_t*)Xv + (size_t)r * DM) + F.lane;
#pragma unroll
            for (int j = 0; j < 4; ++j) { const u32x2 w = xr[64 * j]; v[j] = (f32x4){bflo(w.x), bfhi(w.x), bflo(w.y), bfhi(w.y)}; } }
        else { const f32x4* xr = (const f32x4*)((const float*)Xv + (size_t)r * DM) + F.lane;
#pragma unroll
            for (int j = 0; j < 4; ++j) v[j] = xr[64 * j]; }
#pragma unroll
        for (int j = 0; j < 4; ++j) ss += (v[j].x * v[j].x + v[j].y * v[j].y) + (v[j].z * v[j].z + v[j].w * v[j].w);
        const float rstd = 1.f / sqrtf(wave_sum(ss) * (1.f / DM) + EPS);
        u32x2* o8 = (u32x2*)(H + (size_t)(r - row0) * DM) + F.lane;
#pragma unroll
        for (int j = 0; j < 4; ++j) { const f32x4 y = v[j] * rstd * gs[j] + shv[j]; u32x2 w; w.x = pk2(y.x, y.y); w.y = pk2(y.z, y.w); o8[64 * j] = w; }
    }
}
__device__ __forceinline__ void final_norm_phase(const Ctx& F0, const bf16_t* Xs, int soff, float* out, const float* g, int r0, int r1) {
    const Ctx F = relaunder(F0);
    const int gw = F.bid * NWAVES + F.wave, NGW = F.G * NWAVES;
    f32x4 gs[4];
#pragma unroll
    for (int j = 0; j < 4; ++j) gs[j] = *(const f32x4*)(g + 4 * F.lane + 256 * j);
    for (int r = r0 + gw; r < r1; r += NGW) {
        const u32x2* xr = (const u32x2*)(Xs + (size_t)(r - soff) * DM) + F.lane;
        f32x4 v[4]; float ss = 0.f;
#pragma unroll
        for (int j = 0; j < 4; ++j) { const u32x2 w = xr[64 * j]; v[j] = (f32x4){bflo(w.x), bfhi(w.x), bflo(w.y), bfhi(w.y)}; ss += (v[j].x * v[j].x + v[j].y * v[j].y) + (v[j].z * v[j].z + v[j].w * v[j].w); }
        const float rstd = 1.f / sqrtf(wave_sum(ss) * (1.f / DM) + EPS);
        f32x4* orow = (f32x4*)(out + (size_t)r * DM) + F.lane;
#pragma unroll
        for (int j = 0; j < 4; ++j) orow[64 * j] = v[j] * rstd * gs[j];
    }
}
__device__ __forceinline__ void copy_rows_phase(const Ctx& F0, const bf16_t* src, bf16_t* dst, int nrows) {
    const Ctx F = relaunder(F0);
    const int gw = F.bid * NWAVES + F.wave, NGW = F.G * NWAVES;
    for (int r = gw; r < nrows; r += NGW) { const u32x4* s = (const u32x4*)(src + (size_t)r * DM) + F.lane; u32x4* d = (u32x4*)(dst + (size_t)r * DM) + F.lane; d[0] = s[0]; d[64] = s[64]; }
}
__device__ __forceinline__ void pool_phase(const Ctx& F0, const bf16_t* U, bf16_t* PB) {
    const Ctx F = relaunder(F0);
    const int nitems = (MTOT / 32) * 128;
    for (int it = F.bid * NTHREADS + F.tid; it < nitems; it += F.G * NTHREADS) {
        const int rb = it >> 7, ch = it & 127, t0 = rb * 32, col = ch * 8, w = 2 << (col >> 8), st0 = t0 & 4095;
        float sum[8];
#pragma unroll
        for (int e = 0; e < 8; ++e) sum[e] = 0.f;
        for (int j = 1; j <= w; ++j) if (st0 - j >= 0) { float f[8]; unpack8(*(const u32x4*)(U + (size_t)(t0 - j) * DM + col), f);
#pragma unroll
            for (int e = 0; e < 8; ++e) sum[e] += f[e]; }
        for (int i = 0; i < 32; ++i) {
            const int t = t0 + i, st = st0 + i; float ut[8]; unpack8(*(const u32x4*)(U + (size_t)t * DM + col), ut);
#pragma unroll
            for (int e = 0; e < 8; ++e) sum[e] += ut[e];
            if (st >= w) { float f[8]; unpack8(*(const u32x4*)(U + (size_t)(t - w) * DM + col), f);
#pragma unroll
                for (int e = 0; e < 8; ++e) sum[e] -= f[e]; }
            const float inv = 1.f / (float)min(st + 1, w); float o[8];
#pragma unroll
            for (int e = 0; e < 8; ++e) o[e] = sum[e] * inv - ut[e];
            *(u32x4*)(PB + (size_t)t * DM + col) = pack8(o);
        }
    }
}

template <class Sched>
__device__ __forceinline__ void pool_fix_units(const Ctx& F0, const Sched& S, const bf16_t* U, bf16_t* PB) {
    const Ctx F = relaunder(F0);
    pg8::Unit u;
    for (int i = 0; S.next(i, u); ++i) {
        const int ch = F.tid & 127, rq = F.tid >> 7, col = ch * 8, w = 2 << (col >> 8);
        const int t0 = u.pm * 256 + 4 * rq, st0 = t0 & 4095;
        u32x4 ps[16], xs[4], ys[4];
#pragma unroll
        for (int j = 1; j <= 16; ++j) ps[j - 1] = *(const u32x4*)(U + (size_t)max(t0 - j, 0) * DM + col);
#pragma unroll
        for (int k = 0; k < 4; ++k) { xs[k] = *(const u32x4*)(U + (size_t)(t0 + k) * DM + col); ys[k] = *(const u32x4*)(U + (size_t)max(t0 + k - w, 0) * DM + col); }
        float sum[8];
#pragma unroll
        for (int e = 0; e < 8; ++e) sum[e] = 0.f;
#pragma unroll
        for (int j = 1; j <= 16; ++j) { float f[8]; unpack8(ps[j - 1], f); const float m = (j <= w && st0 - j >= 0) ? 1.f : 0.f;
#pragma unroll
            for (int e = 0; e < 8; ++e) sum[e] += m * f[e]; }
#pragma unroll
        for (int k = 0; k < 4; ++k) { const int t = t0 + k, st = st0 + k; float ut[8], f[8]; unpack8(xs[k], ut); unpack8(ys[k], f);
            const float m = (st >= w) ? 1.f : 0.f;
#pragma unroll
            for (int e = 0; e < 8; ++e) sum[e] += ut[e] - m * f[e];
            const float inv = 1.f / (float)min(st + 1, w); float o[8];
#pragma unroll
            for (int e = 0; e < 8; ++e) o[e] = sum[e] * inv - ut[e];
            *(u32x4*)(PB + (size_t)t * DM + col) = pack8(o); }
    }
    asm volatile("s_waitcnt vmcnt(0)" ::: "memory");
    __syncthreads();
}

template <class Sched>
__device__ __forceinline__ void conv_fix_units(const Ctx& F0, const Sched& S, bf16_t* G, const float* cw, const float* cb, const float* halo, const float* raw0, int row0) {
    const Ctx F = relaunder(F0);
    pg8::Unit u;
    for (int i = 0; S.next(i, u); ++i) {
        const int tile = u.pm;
        if (F.tid < 352) {
            const int col = F.tid * 8;
            const bool seq0 = (((row0 + tile * 256) & 4095) == 0);
            float h254[8], h255[8];
#pragma unroll
            for (int e = 0; e < 8; ++e) { h254[e] = 0.f; h255[e] = 0.f; }
            if (!seq0) { const float* hp = halo + ((size_t)(tile - 1) * 2) * FF + col;
#pragma unroll
                for (int e = 0; e < 8; ++e) { h254[e] = hp[e]; h255[e] = hp[FF + e]; } }
            const float* rp = raw0 + ((size_t)tile * 2) * NUP + col;
            float o0[8], o1[8];
#pragma unroll
            for (int e = 0; e < 8; ++e) { const float a0 = rp[e], v0 = rp[FF + e], a1 = rp[NUP + e], v1 = rp[NUP + FF + e];
                const float w0 = cw[col + e], w1 = cw[FF + col + e], w2 = cw[2 * FF + col + e], bb = cb[col + e];
                const float y0 = bb + w0 * h254[e] + w1 * h255[e] + w2 * a0, y1 = bb + w0 * h255[e] + w1 * a0 + w2 * a1;
                o0[e] = y0 / (1.f + __expf(-y0)) * v0; o1[e] = y1 / (1.f + __expf(-y1)) * v1; }
            *(u32x4*)(G + (size_t)(tile * 256) * FF + col) = pack8(o0); *(u32x4*)(G + (size_t)(tile * 256 + 1) * FF + col) = pack8(o1);
        }
    }
    asm volatile("s_waitcnt vmcnt(0)" ::: "memory");
    __syncthreads();
}

__device__ __forceinline__ int crow(int r, int hi) { return (r & 3) + 8 * (r >> 2) + 4 * hi; }
__device__ __forceinline__ void attn_phase(const Ctx& F0, bf16_t* Qc, const bf16_t* KVc, float* LSE) {
    const Ctx F = relaunder(F0);
    LAS unsigned char* lds = F.lds;
    const int tid = F.tid, lane = F.lane, wid = F.wave, q = lane & 31, hi = lane >> 5;
    constexpr size_t MAT = (size_t)MC * 1024;
    constexpr int VOFF = 49152, NUNITS = 3072;
    const int q4 = (lane & 15) >> 2, p4 = lane & 3, dc16 = (lane >> 4) & 1;
    const int slot_l = tid >> 3, c_l = tid & 7;
    u32x4 kreg[6], vreg[6]; bf16x8 qn[4];
#define ATT_DECODE(u, h, rb, g, sh, prow0, has_prev) const int h = (u) & 15, rb = ((u) >> 4) & 63, g = (u) >> 10, sh = 2 * g, prow0 = rb * 256; const bool has_prev = ((prow0 & ((4096 >> sh) - 1)) != 0)
#define ATT_ISSUE(u) do { ATT_DECODE(u, h_, rb_, g_, sh_, prow0_, hp_); \
        const bf16_t* Kg_ = KVc + (size_t)g_ * MAT + (size_t)h_ * MC * 64 + c_l * 8; const bf16_t* Vg_ = KVc + (size_t)(3 + g_) * MAT + (size_t)h_ * MC * 64 + c_l * 8; \
        _Pragma("unroll") for (int i = 0; i < 6; ++i) if (hp_ || i >= 2) { const long prow = (long)prow0_ - 128 + slot_l + 64 * i; kreg[i] = *(const u32x4*)(Kg_ + prow * 64); vreg[i] = *(const u32x4*)(Vg_ + prow * 64); } \
        const bf16_t* Qw_ = Qc + (size_t)g_ * MAT + ((size_t)h_ * MC + prow0_ + 32 * wid + q) * 64; \
        _Pragma("unroll") for (int s = 0; s < 4; ++s) qn[s] = *(const bf16x8*)(Qw_ + 16 * s + 8 * hi); } while (0)
    int u = F.bid;
    if (u < NUNITS) ATT_ISSUE(u);
    while (u < NUNITS) {
        ATT_DECODE(u, h, rb, g, sh, prow0, has_prev);
        bf16_t* Qw = Qc + (size_t)g * MAT + ((size_t)h * MC + prow0 + 32 * wid + q) * 64;
        bf16x8 qf[4];
#pragma unroll
        for (int s = 0; s < 4; ++s) qf[s] = qn[s];
#pragma unroll
        for (int i = 0; i < 6; ++i) if (has_prev || i >= 2) { const int slot = slot_l + 64 * i;
            *(LAS u32x4*)(lds + slot * 128 + ((c_l ^ ((slot >> 1) & 7)) << 4)) = kreg[i];
            *(LAS u32x4*)(lds + VOFF + slot * 128 + ((c_l << 4) ^ (((slot >> 1) & 1) << 6))) = vreg[i]; }
        __syncthreads();
        const int un = u + F.G;
        if (un < NUNITS) ATT_ISSUE(un);
        const int ii = g * 16 + h; const float ee = ii < 32 ? 0.125f * (float)(ii + 1) : 4.0f + 0.25f * (float)(ii - 31);
        const float slope2 = exp2f(-ee) * (float)(1 << sh) * LOG2E;
        float mx = -INFINITY, lsum = 0.f;
        f32x16 o0 = {0.f, 0.f, 0.f, 0.f, 0.f, 0.f, 0.f, 0.f, 0.f, 0.f, 0.f, 0.f, 0.f, 0.f, 0.f, 0.f}, o1 = o0;
        f32x16 cf;
#pragma unroll
        for (int r = 0; r < 16; ++r) cf[r] = slope2 * (float)crow(r, hi);
        const int qq = q - 4 * hi;
        const int i0 = has_prev ? 0 : (wid < 4 ? 4 - wid : 0);
#define ATT_TILE(i, MASKLO, MASKHI) do { \
            const int sb = 32 * wid + 32 * (i); \
            const float base = -slope2 * (float)(q + 128 - 32 * (i)); \
            f32x16 a; \
            _Pragma("unroll") for (int r = 0; r < 16; ++r) a[r] = cf[r] + base; \
            { const int slot = sb + q; \
              _Pragma("unroll") for (int s = 0; s < 4; ++s) { const int c = 2 * s + hi; const bf16x8 kf = *(const LAS bf16x8*)(lds + slot * 128 + ((c ^ ((slot >> 1) & 7)) << 4)); \
                  a = __builtin_amdgcn_mfma_f32_32x32x16_bf16(kf, qf[s], a, 0, 0, 0); } } \
            if (MASKHI) { _Pragma("unroll") for (int r = 0; r < 16; ++r) if (crow(r, 0) > qq) a[r] = -INFINITY; }     \
            if (MASKLO) { _Pragma("unroll") for (int r = 0; r < 16; ++r) if (crow(r, 0) < qq) a[r] = -INFINITY; }     \
            float tmax = fmaxf(fmaxf(a[0], a[1]), fmaxf(a[2], a[3])); \
            _Pragma("unroll") for (int r = 4; r < 16; r += 4) tmax = fmaxf(tmax, fmaxf(fmaxf(a[r], a[r + 1]), fmaxf(a[r + 2], a[r + 3]))); \
            tmax = fmaxf(tmax, __shfl_xor(tmax, 32)); \
            if (__any(tmax > mx)) { const float mnew = fmaxf(mx, tmax); const float alpha = __builtin_amdgcn_exp2f(mx - mnew); mx = mnew; lsum *= alpha; \
                _Pragma("unroll") for (int r = 0; r < 16; ++r) { o0[r] *= alpha; o1[r] *= alpha; } } \
            float ps = 0.f; \
            _Pragma("unroll") for (int r = 0; r < 16; ++r) { const float p = __builtin_amdgcn_exp2f(a[r] - mx); a[r] = p; ps += p; } \
            lsum += ps; \
            _Pragma("unroll") for (int s2 = 0; s2 < 2; ++s2) { \
                u32x4 pw; pw.x = cvt_pk_bf16(a[8 * s2 + 0], a[8 * s2 + 1]); pw.y = cvt_pk_bf16(a[8 * s2 + 2], a[8 * s2 + 3]); \
                pw.z = cvt_pk_bf16(a[8 * s2 + 4], a[8 * s2 + 5]); pw.w = cvt_pk_bf16(a[8 * s2 + 6], a[8 * s2 + 7]); \
                const bf16x8 pf = __builtin_bit_cast(bf16x8, pw); \
                const int slotA = sb + 16 * s2 + 4 * hi + q4; \
                _Pragma("unroll") for (int dh = 0; dh < 2; ++dh) { \
                    const int colb = (32 * dh + 16 * dc16 + 4 * p4) * 2; \
                    const int addr = VOFF + slotA * 128 + (colb ^ (((slotA >> 1) & 1) << 6)); \
                    const s16x4 lo = __builtin_bit_cast(s16x4, __builtin_amdgcn_ds_read_tr16_b64_v4i16((LAS s16x4*)(lds + addr))); \
                    const s16x4 hh = __builtin_bit_cast(s16x4, __builtin_amdgcn_ds_read_tr16_b64_v4i16((LAS s16x4*)(lds + addr + 1024))); \
                    const bf16x8 vf = (bf16x8){lo[0], lo[1], lo[2], lo[3], hh[0], hh[1], hh[2], hh[3]}; \
                    if (dh == 0) o0 = __builtin_amdgcn_mfma_f32_32x32x16_bf16(vf, pf, o0, 0, 0, 0); \
                    else o1 = __builtin_amdgcn_mfma_f32_32x32x16_bf16(vf, pf, o1, 0, 0, 0); } } \
        } while (0)
        ATT_TILE(4, false, true);
        for (int i = 3; i >= 1 && i >= i0; --i) ATT_TILE(i, false, false);
        if (i0 == 0) ATT_TILE(0, true, false);
#undef ATT_TILE
        lsum += __shfl_xor(lsum, 32);
        const float inv = 1.f / lsum;
#pragma unroll
        for (int rq = 0; rq < 4; ++rq) {
            u32x2 w0; w0.x = cvt_pk_bf16(o0[4 * rq + 0] * inv, o0[4 * rq + 1] * inv); w0.y = cvt_pk_bf16(o0[4 * rq + 2] * inv, o0[4 * rq + 3] * inv);
            u32x2 w1; w1.x = cvt_pk_bf16(o1[4 * rq + 0] * inv, o1[4 * rq + 1] * inv); w1.y = cvt_pk_bf16(o1[4 * rq + 2] * inv, o1[4 * rq + 3] * inv);
            *(u32x2*)(Qw + 8 * rq + 4 * hi) = w0; *(u32x2*)(Qw + 32 + 8 * rq + 4 * hi) = w1;
        }
        if (hi == 0) LSE[((size_t)g * MC + prow0 + 32 * wid + q) * 16 + h] = mx + log2f(lsum);
        __syncthreads();
        u = un;
    }
#undef ATT_DECODE
#undef ATT_ISSUE
}
__device__ __forceinline__ void merge_phase(const Ctx& F0, const bf16_t* Oc, const float* LSE, bf16_t* OM) {
    const Ctx F = relaunder(F0);
    const int gw = F.bid * NWAVES + F.wave, NGW = F.G * NWAVES;
    constexpr size_t MAT = (size_t)MC * 1024;
    const int col = F.lane * 16, h = F.lane >> 2;
    for (int r = gw; r < MC; r += NGW) {
        const int tt = r & 4095, bb = r & ~4095;
        int pr[3]; float l[3];
#pragma unroll
        for (int g = 0; g < 3; ++g) { const int sh = 2 * g; pr[g] = bb + ((tt & ((1 << sh) - 1)) << (12 - sh)) + (tt >> sh); l[g] = LSE[((size_t)g * MC + pr[g]) * 16 + h]; }
        const float mx = fmaxf(l[0], fmaxf(l[1], l[2]));
        float w[3]; w[0] = exp2f(l[0] - mx); w[1] = exp2f(l[1] - mx); w[2] = exp2f(l[2] - mx);
        const float inv = 1.f / (w[0] + w[1] + w[2]);
        float acc[16];
#pragma unroll
        for (int e = 0; e < 16; ++e) acc[e] = 0.f;
#pragma unroll
        for (int g = 0; g < 3; ++g) { const bf16_t* p = Oc + (size_t)g * MAT + ((size_t)h * MC + pr[g]) * 64 + (F.lane & 3) * 16; float f0[8], f1[8]; unpack8(*(const u32x4*)p, f0); unpack8(*(const u32x4*)(p + 8), f1);
            const float wg = w[g] * inv;
#pragma unroll
            for (int e = 0; e < 8; ++e) { acc[e] += wg * f0[e]; acc[8 + e] += wg * f1[e]; } }
        float o0[8], o1[8];
#pragma unroll
        for (int e = 0; e < 8; ++e) { o0[e] = acc[e]; o1[e] = acc[8 + e]; }
        bf16_t* op = OM + (size_t)r * DM + col; *(u32x4*)op = pack8(o0); *(u32x4*)(op + 8) = pack8(o1);
    }
}

#define XB_TMO      128
#define XB_XCNT(j)  (256  + 64 * (j))
#define XB_XSUB(j)  (1280 + 64 * (j))
#define XB_XGEN(j)  (2304 + 64 * (j))
#define XB_TOP      3328
#define XB_TOPGEN   3392
#define XCD_BAR_WORDS 3456
#define XB_SPIN_CAP (1u << 18)
__device__ __forceinline__ unsigned xb_ld(unsigned* p)              { return __hip_atomic_load(p, __ATOMIC_RELAXED, __HIP_MEMORY_SCOPE_AGENT); }
__device__ __forceinline__ unsigned xb_add(unsigned* p, unsigned v) { return __hip_atomic_fetch_add(p, v, __ATOMIC_RELAXED, __HIP_MEMORY_SCOPE_AGENT); }
__device__ __forceinline__ unsigned xb_xcc_id() { return (unsigned)__builtin_amdgcn_s_getreg((3 << 11) | 20) & 0xFu; }
#define XB_SPIN(cond, bar) do { unsigned _sp = 0; while (cond) { __builtin_amdgcn_s_sleep(1); \
    if ((++_sp & 255u) == 0u) { if (xb_ld(&(bar)[XB_TMO])) break; if (_sp > XB_SPIN_CAP) { atomicAdd(&(bar)[XB_TMO], 1u); break; } } } } while (0)
struct XcdBarrier { unsigned* bar; unsigned x; volatile LAS unsigned* st; };
__device__ __forceinline__ XcdBarrier xcd_barrier_post(unsigned* bar, volatile LAS unsigned* st) {
    XcdBarrier b; b.bar = bar; b.x = xb_xcc_id(); b.st = st;
    if (threadIdx.x == 0) (void)xb_add(&bar[XB_XCNT(b.x)], 1u);
    return b;
}
__device__ __forceinline__ void xcd_barrier_complete(unsigned* bar, unsigned x, unsigned& nloc, unsigned& nx) {
    const unsigned G = gridDim.x * gridDim.y * gridDim.z;
    unsigned sum, cnt, mine, sp = 0u;
    for (;;) {
        sum = 0u; cnt = 0u; mine = 0u;
#pragma unroll
        for (unsigned j = 0; j < 16; ++j) { const unsigned c = xb_ld(&bar[XB_XCNT(j)]); sum += c; cnt += (c > 0u) ? 1u : 0u; mine = (j == x) ? c : mine; }
        if (sum == G) break;
        __builtin_amdgcn_s_sleep(1);
        if ((++sp & 255u) == 0u) { if (xb_ld(&bar[XB_TMO])) break; if (sp > XB_SPIN_CAP) { atomicAdd(&bar[XB_TMO], 1u); break; } }
    }
    nloc = mine > 0u ? mine : 1u; nx = cnt > 0u ? cnt : 1u;
}
__device__ __forceinline__ void xcd_barrier(const XcdBarrier& b) {
    asm volatile("s_waitcnt vmcnt(0)" ::: "memory");
    __syncthreads();
    int t0_ = threadIdx.x; asm volatile("" : "+v"(t0_));
    if (t0_ == 0) {
        unsigned* bar = b.bar; unsigned bx = b.x; asm volatile("" : "+s"(bx));
        __builtin_amdgcn_s_waitcnt(0);
        unsigned nloc = b.st[0], nx = b.st[1];
        if (nloc == 0u) { xcd_barrier_complete(bar, bx, nloc, nx); b.st[0] = nloc; b.st[1] = nx; }
        const unsigned old = xb_add(&bar[XB_XSUB(bx)], 1u);
        const unsigned gen = old / nloc;
        if (old + 1u == (gen + 1u) * nloc) {
            __builtin_amdgcn_fence(__ATOMIC_RELEASE, "agent");
            asm volatile("s_waitcnt vmcnt(0)" ::: "memory");
            const unsigned og = xb_add(&bar[XB_TOP], 1u);
            const unsigned tg = og / nx;
            if (og + 1u == (tg + 1u) * nx) xb_add(&bar[XB_TOPGEN], 1u);
            else XB_SPIN(xb_ld(&bar[XB_TOPGEN]) == tg, bar);
            __builtin_amdgcn_fence(__ATOMIC_ACQUIRE, "agent");
            xb_add(&bar[XB_XGEN(bx)], 1u);
            asm volatile("s_waitcnt vmcnt(0)" ::: "memory");
        } else {
            XB_SPIN(xb_ld(&bar[XB_XGEN(bx)]) == gen, bar);
            __builtin_amdgcn_fence(__ATOMIC_ACQUIRE, "agent");
            asm volatile("s_waitcnt vmcnt(0)" ::: "memory");
        }
    }
    __syncthreads();
}

struct Args { const float* in[21]; float* out; unsigned char* ws; };
enum { I_X = 0, I_C, I_ADAW, I_ADAB, I_N1G, I_N2G, I_PWIN, I_PWGRP, I_PSCALE, I_PWOUT, I_KVNG, I_KVADAW, I_KVADAB, I_WKV, I_WQ, I_WO, I_WUP, I_CONVW, I_CONVB, I_WDN, I_FING };

__global__ void __launch_bounds__(NTHREADS, 2) mega_fwd(Args a) {
    extern __shared__ __attribute__((aligned(16))) unsigned char lds_raw[];
    cg::grid_group grid = cg::this_grid();
    Ctx F; F.lds = (LAS unsigned char*)lds_raw; F.tid = threadIdx.x; F.lane = F.tid & 63; F.wave = __builtin_amdgcn_readfirstlane(F.tid >> 6); F.bid = blockIdx.x; F.G = gridDim.x;
    unsigned char* ws = a.ws;
    float* mod = (float*)(ws + WS_MOD); float* kvmod = (float*)(ws + WS_KVMOD);
    bf16_t* X = (bf16_t*)((unsigned char*)a.out + 64 * MiB);
    float* halo = (float*)(ws + WS_HALO); float* raw0 = (float*)(ws + WS_RAW0);
    LAS float* xch = (LAS float*)(F.lds + 131072 + 4096);
#define GSYNC_CG() do { asm volatile("s_waitcnt vmcnt(0)" ::: "memory"); grid.sync(); __builtin_amdgcn_fence(__ATOMIC_ACQUIRE, "agent"); } while (0)
#define GSYNC() xcd_barrier(bar)
    volatile LAS unsigned* MISC = (volatile LAS unsigned*)(F.lds + 131072 + 320);
    if (F.tid < 32) MISC[F.tid] = 0u;
    unsigned* barw = (unsigned*)(ws + WS_BAR);
    __syncthreads();

    for (int L = 0; L < 2; ++L) {
        transpose_matrix(F, a.in[I_PWIN] + (size_t)L * DM * DM, DM, DM, (bf16_t*)(ws + WA_WIN) + (size_t)L * DM * DM, 0);
        transpose_matrix<true>(F, a.in[I_WUP] + (size_t)L * DM * NUP, DM, NUP, (bf16_t*)(ws + WA_WUP) + (size_t)L * DM * NUP, 0);
        transpose_matrix(F, a.in[I_WDN] + (size_t)L * FF * DM, FF, DM, (bf16_t*)(ws + WA_WDN) + (size_t)L * FF * DM, 0);
    }
    fold_pool_weights(F, a.in[I_PWGRP], a.in[I_PSCALE], a.in[I_PWOUT], (bf16_t*)(ws + WA_WOUT));
    mod_phase(F, a.in[I_C], a.in[I_ADAW], a.in[I_ADAB], a.in[I_KVADAW], a.in[I_KVADAB], mod, kvmod);
    const XcdBarrier bar = xcd_barrier_post(barw, MISC + 8);
    if (a.ws == nullptr) GSYNC_CG();
    GSYNC();

    for (int L = 0; L < 2; ++L) {
        const float* modL = mod + (size_t)L * 8 * 6144;
        bf16_t* H = (bf16_t*)(ws + WA_H); bf16_t* U = (bf16_t*)(ws + WA_U); bf16_t* PB = (bf16_t*)(ws + WA_PB); bf16_t* AV = (bf16_t*)(ws + WA_AV);
        if (L == 0) norm_phase<false>(F, a.in[I_X], H, a.in[I_N1G] + L * DM, modL + 0, modL + 1024, 6144, 0, MTOT);
        else norm_phase<true>(F, X, H, a.in[I_N1G] + L * DM, modL + 0, modL + 1024, 6144, 0, MTOT);
        GSYNC();
        { pg8::Gemm g{H, (bf16_t*)(ws + WA_WIN) + (size_t)L * DM * DM, MTOT, DM, DM, DM, DM, 0}; pg8::StaticOrder S; S.init(MTOT, DM, F.G, F.bid);
          pg8::EpiPoolU E{U, PB}; pg8::gemm_phase(F.lds, g, S, E); }
        GSYNC();
        { pg8::Gemm g{PB, (bf16_t*)(ws + WA_WOUT) + (size_t)L * DM * DM, MTOT, DM, DM, DM, DM, 0}; pg8::StaticOrder S; S.init(MTOT, DM, F.G, F.bid);
          pool_fix_units(F, S, U, PB);
          if (L == 0) { pg8::EpiResid<true> E{a.in[I_X], nullptr, X, modL + 2048, 0}; pg8::gemm_phase(F.lds, g, S, E); }
          else { pg8::EpiResid<false> E{nullptr, X, X, modL + 2048, 0}; pg8::gemm_phase(F.lds, g, S, E); } }
        GSYNC();
        norm_phase<true>(F, X, H, a.in[I_N2G] + L * DM, modL + 3072, modL + 4096, 6144, 0, MTOT);
        GSYNC();
        { pg8::Gemm g{H, (bf16_t*)(ws + WA_WUP) + (size_t)L * DM * NUP, MTOT, NUP, DM, DM, DM, 0}; pg8::StaticOrder S; S.init(MTOT, NUP, F.G, F.bid);
          pg8::EpiConvGate E{AV, a.in[I_CONVW] + (size_t)L * 3 * FF, a.in[I_CONVB] + (size_t)L * FF, halo, raw0, xch}; pg8::gemm_phase(F.lds, g, S, E); }
        GSYNC();
        { pg8::Gemm g{AV, (bf16_t*)(ws + WA_WDN) + (size_t)L * FF * DM, MTOT, DM, FF, FF, FF, 0}; pg8::StaticOrder S; S.init(MTOT, DM, F.G, F.bid);
          conv_fix_units(F, S, AV, a.in[I_CONVW] + (size_t)L * 3 * FF, a.in[I_CONVB] + (size_t)L * FF, halo, raw0, 0);
          pg8::EpiResid<false> E{nullptr, X, X, modL + 5120, 0}; pg8::gemm_phase(F.lds, g, S, E); }
        GSYNC();
    }

    transpose_matrix(F, a.in[I_WKV], DM, 6144, (bf16_t*)(ws + WB_WKV), 0);
    for (int j = 0; j < 2; ++j) {
        transpose_matrix(F, a.in[I_WQ] + (size_t)j * DM * 3072, DM, 3072, (bf16_t*)(ws + WB_WQ) + (size_t)j * DM * 3072, 0);
        transpose_matrix(F, a.in[I_WO] + (size_t)j * DM * DM, DM, DM, (bf16_t*)(ws + WB_WO) + (size_t)j * DM * DM, 0);
        transpose_matrix<true>(F, a.in[I_WUP] + (size_t)(2 + j) * DM * NUP, DM, NUP, (bf16_t*)(ws + WB_WUP) + (size_t)j * DM * NUP, 0);
        transpose_matrix(F, a.in[I_WDN] + (size_t)(2 + j) * FF * DM, FF, DM, (bf16_t*)(ws + WB_WDN) + (size_t)j * FF * DM, 0);
    }
    __syncthreads();

    for (int c = 0; c < 2; ++c) {
        const int row0 = c * MC;
        bf16_t* H = (bf16_t*)(ws + WB_H); bf16_t* KVc = (bf16_t*)(ws + WB_KV); bf16_t* Qc = (bf16_t*)(ws + WB_Q); bf16_t* AV = (bf16_t*)(ws + WB_AV); float* LSE = (float*)(ws + WB_LSE);
        bf16_t* H2 = (bf16_t*)(ws + WB_H2);
        { const float* mod2 = mod + (size_t)2 * 8 * 6144;
          norm_phase<true>(F, X, H, a.in[I_KVNG], kvmod + 0, kvmod + 1024, 2048, row0, MC);
          norm_phase<true>(F, X, H2, a.in[I_N1G] + 2 * DM, mod2 + 0, mod2 + 1024, 6144, row0, MC); }
        GSYNC();
        { pg8::Gemm g{H, (bf16_t*)(ws + WB_WKV), MC, 6144, DM, DM, DM, 0}; pg8::StaticOrder S; S.init(MC, 6144, F.G, F.bid);
          pg8::EpiQKV E{KVc, (size_t)MC * 1024, 1.0f}; pg8::gemm_phase(F.lds, g, S, E); }
        { pg8::Gemm g{H2, (bf16_t*)(ws + WB_WQ), MC, 3072, DM, DM, DM, 0}; pg8::StaticOrder S; S.init(MC, 3072, F.G, F.bid);
          pg8::EpiQKV E{Qc, (size_t)MC * 1024, 0.125f * LOG2E}; pg8::gemm_phase(F.lds, g, S, E); }
        GSYNC();
        for (int j = 0; j < 2; ++j) {
            const int L = 2 + j; const float* modL = mod + (size_t)L * 8 * 6144;
            if (j == 1) {
                norm_phase<true>(F, X, H, a.in[I_N1G] + L * DM, modL + 0, modL + 1024, 6144, row0, MC);
                GSYNC();
                { pg8::Gemm g{H, (bf16_t*)(ws + WB_WQ) + (size_t)j * DM * 3072, MC, 3072, DM, DM, DM, 0}; pg8::StaticOrder S; S.init(MC, 3072, F.G, F.bid);
                  pg8::EpiQKV E{Qc, (size_t)MC * 1024, 0.125f * LOG2E}; pg8::gemm_phase(F.lds, g, S, E); }
                GSYNC();
            }
            attn_phase(F, Qc, KVc, LSE);
            GSYNC();
            merge_phase(F, Qc, LSE, H);
            GSYNC();
            { pg8::Gemm g{H, (bf16_t*)(ws + WB_WO) + (size_t)j * DM * DM, MC, DM, DM, DM, DM, 0}; pg8::StaticOrder S; S.init(MC, DM, F.G, F.bid);
              pg8::EpiResid<false> E{nullptr, X, X, modL + 2048, row0}; pg8::gemm_phase(F.lds, g, S, E); }
            GSYNC();
            norm_phase<true>(F, X, H, a.in[I_N2G] + L * DM, modL + 3072, modL + 4096, 6144, row0, MC);
            GSYNC();
            { pg8::Gemm g{H, (bf16_t*)(ws + WB_WUP) + (size_t)j * DM * NUP, MC, NUP, DM, DM, DM, 0}; pg8::StaticOrder S; S.init(MC, NUP, F.G, F.bid);
              pg8::EpiConvGate E{AV, a.in[I_CONVW] + (size_t)L * 3 * FF, a.in[I_CONVB] + (size_t)L * FF, halo, raw0, xch}; pg8::gemm_phase(F.lds, g, S, E); }
            GSYNC();
            { pg8::Gemm g{AV, (bf16_t*)(ws + WB_WDN) + (size_t)j * FF * DM, MC, DM, FF, FF, FF, 0}; pg8::StaticOrder S; S.init(MC, DM, F.G, F.bid);
              conv_fix_units(F, S, AV, a.in[I_CONVW] + (size_t)L * 3 * FF, a.in[I_CONVB] + (size_t)L * FF, halo, raw0, row0);
              bf16_t* Xo = (c == 1 && j == 1) ? (bf16_t*)(ws + WS_XTAIL) - (size_t)MC * DM : X;
              pg8::EpiResid<false> E{nullptr, X, Xo, modL + 5120, row0}; pg8::gemm_phase(F.lds, g, S, E); }
            GSYNC();
        }
    }
    final_norm_phase(F, X, 0, a.out, a.in[I_FING], 0, MC);
    GSYNC();
    final_norm_phase(F, (const bf16_t*)(ws + WS_XTAIL), MC, a.out, a.in[I_FING], MC, MTOT);
}

extern "C" void kernel_launch(void* const* d_in, const int* in_sizes, int n_in, void* d_out, int out_size, void* d_ws, size_t ws_size, hipStream_t stream) {
    static int grid = 0;
    if (grid == 0) {
        int dev = 0, cus = 0, per_cu = 0;
        if (n_in != 21 || out_size != MTOT * DM || ws_size < 512 * MiB) { fprintf(stderr, "kernel_launch: unexpected problem (n_in %d, out %d, ws %zu)\n", n_in, out_size, ws_size); grid = -1; return; }
        if (hipGetDevice(&dev) != hipSuccess || hipDeviceGetAttribute(&cus, hipDeviceAttributeMultiprocessorCount, dev) != hipSuccess) { grid = -1; return; }
        if (hipFuncSetAttribute((const void*)mega_fwd, hipFuncAttributeMaxDynamicSharedMemorySize, LDS_BYTES) != hipSuccess) { fprintf(stderr, "kernel_launch: hipFuncSetAttribute failed\n"); grid = -1; return; }
        if (hipOccupancyMaxActiveBlocksPerMultiprocessor(&per_cu, (const void*)mega_fwd, NTHREADS, LDS_BYTES) != hipSuccess || per_cu < 1) { fprintf(stderr, "kernel_launch: occupancy query says %d\n", per_cu); per_cu = 1; }
        (void)hipGetLastError();
        grid = cus;
    }
    if (grid < 0) return;
    Args a{};
    for (int i = 0; i < 21; ++i) a.in[i] = (const float*)d_in[i];
    a.out = (float*)d_out; a.ws = (unsigned char*)d_ws;
    if (hipMemsetAsync((unsigned char*)d_ws + WS_BAR, 0, XCD_BAR_WORDS * 4, stream) != hipSuccess) { fprintf(stderr, "kernel_launch: memset of the barrier words failed\n"); return; }
    void* args[] = {&a};
    hipError_t e = hipLaunchCooperativeKernel((const void*)mega_fwd, dim3(grid), dim3(NTHREADS), args, LDS_BYTES, stream);
    if (e != hipSuccess) fprintf(stderr, "kernel_launch: cooperative launch failed: %s (grid %d)\n", hipGetErrorString(e), grid);
}
```
